# Optimizing an MI355X kernel written in HIP

```python
import math
import jax, jax.numpy as jnp
from jax import lax
import numpy as np

D_MODEL = 1024
BATCH = 32
SEQ = 256
DEPTH = 2
DEC_BATCH = 2
DEC_SEQ = 1024
PAST_LEN = 512

GRID_W = 64
H_A = 4
DH_A = 64
W_A = H_A * 2 * DH_A
H_B = 8
P_B = 64
G_B = 2
N_B = 64
DI_B = H_B * P_B
CONV_K = 5
CONV_DIM = DI_B + 2 * G_B * N_B
SSD_CHUNK = 128
H_C = 8
DH_C = 64
W_C = H_C * DH_C
NA_KH = 8
NA_KW = 16
N_BRANCH = 3
ROPE_BASE = 10000.0
Q_BLOCK = 128
EPS = 1e-6
IN_SIZES = (W_A, W_A, W_A, W_A,
            DI_B, CONV_DIM, 2 * H_B,
            W_C, W_C, W_C, W_C,
            N_BRANCH * D_MODEL)
IN_COLS = sum(IN_SIZES)

kernel_name = 'hybrid_diffattn_ssd_natten_prefix_step'


def _rmsnorm(x, g):
    xf = x.astype(jnp.float32)
    y = xf * lax.rsqrt(jnp.mean(xf * xf, axis=-1, keepdims=True) + EPS)
    return (y * g.astype(jnp.float32)).astype(x.dtype)


def _softmax32(s):
    return jax.nn.softmax(s.astype(jnp.float32), axis=-1)


def _query_blocks(fn, qs):
    b, t = qs[0].shape[:2]
    blk = math.gcd(t, Q_BLOCK)
    nb = t // blk
    split = lambda a: jnp.moveaxis(a.reshape((b, nb, blk) + a.shape[2:]), 1, 0)
    out = lax.map(fn, tuple(split(a) for a in qs))
    out = jnp.moveaxis(out, 0, 1)
    return out.reshape((b, t) + out.shape[3:])


def _axial_rope(x):
    t, dh = x.shape[1], x.shape[-1]
    half = dh // 2
    quarter = half // 2
    pos = jnp.arange(t)
    inv = ROPE_BASE ** (-jnp.arange(quarter, dtype=jnp.float32) / quarter)

    def rot(u, p):
        ang = p.astype(jnp.float32)[:, None] * inv[None, :]
        bshape = (1, t) + (1,) * (u.ndim - 3) + (quarter,)
        cos, sin = jnp.cos(ang).reshape(bshape), jnp.sin(ang).reshape(bshape)
        u1 = u[..., :quarter].astype(jnp.float32)
        u2 = u[..., quarter:].astype(jnp.float32)
        return jnp.concatenate([u1 * cos - u2 * sin, u2 * cos + u1 * sin], axis=-1)

    out = jnp.concatenate([rot(x[..., :half], pos // GRID_W), rot(x[..., half:], pos % GRID_W)], axis=-1)
    return out.astype(x.dtype)


def _diff_lambda(lq1, lk1, lq2, lk2, lam_init):
    f = lambda a, b: jnp.exp(jnp.sum(a.astype(jnp.float32) * b.astype(jnp.float32)))
    return f(lq1, lk1) - f(lq2, lk2) + lam_init


def _diff_attention(q, k, v, lam):
    scale = DH_A ** -0.5

    def block(args):
        (qb,) = args
        p = _softmax32(jnp.einsum('bqhmd,bkhmd->bhmqk', qb, k) * scale)
        p = p[:, :, 0] - lam * p[:, :, 1]
        return jnp.einsum('bhqk,bkhe->bqhe', p.astype(v.dtype), v)

    return _query_blocks(block, (q,))


def _diff_post(o, subln_g, lam_init):
    o = _rmsnorm(o, subln_g) * (1.0 - lam_init)
    return o.reshape(o.shape[:2] + (W_A,))


def _softmax_attention(q, k, v):
    scale = q.shape[-1] ** -0.5

    def block(args):
        (qb,) = args
        p = _softmax32(jnp.einsum('bqhd,bkhd->bhqk', qb, k) * scale)
        return jnp.einsum('bhqk,bkhd->bqhd', p.astype(v.dtype), v)

    return _query_blocks(block, (q,))


def _neighborhood_attention(q, k, v, ck, cv, rpb):
    b, t, h, d = q.shape
    rows = t // GRID_W
    kh, kw = min(NA_KH, rows), NA_KW
    scale = d ** -0.5
    grid = lambda a: a.reshape(b, rows, GRID_W, h, d)
    qg, kg, vg = grid(q), grid(k), grid(v)
    r = jnp.arange(rows)
    row_idx = jnp.clip(r - kh // 2, 0, rows - kh)[:, None] + jnp.arange(kh)[None, :]
    k_rows = jnp.take(kg, row_idx, axis=1)
    v_rows = jnp.take(vg, row_idx, axis=1)
    col = jnp.arange(GRID_W)
    col_start = jnp.clip(col - kw // 2, 0, GRID_W - kw)
    in_win = (col[None, :] >= col_start[:, None]) & (col[None, :] < col_start[:, None] + kw)
    dr = row_idx - r[:, None] + (NA_KH - 1)
    dc = jnp.clip(col[None, :] - col[:, None], -(kw - 1), kw - 1) + (kw - 1)
    bias = rpb[:, dr[:, None, :, None], dc[None, :, None, :]].astype(jnp.float32)
    s_win = jnp.einsum('brqhd,brikhd->bhrqik', qg, k_rows).astype(jnp.float32) * scale + bias[None]
    s_win = jnp.where(in_win[:, None, :], s_win, -jnp.inf)
    s_ctx = jnp.einsum('brqhd,bphd->bhrqp', qg, ck).astype(jnp.float32) * scale
    nwin = kh * GRID_W
    p = _softmax32(jnp.concatenate([s_win.reshape(b, h, rows, GRID_W, nwin), s_ctx], axis=-1))
    p_win = p[..., :nwin].reshape(b, h, rows, GRID_W, kh, GRID_W).astype(v.dtype)
    p_ctx = p[..., nwin:].astype(v.dtype)
    o = jnp.einsum('bhrqik,brikhd->brqhd', p_win, v_rows) + jnp.einsum('bhrqp,bphd->brqhd', p_ctx, cv)
    return o.reshape(b, t, h * d)


def _centred_depthwise_conv(u, w, bias):
    c = u.shape[-1]
    out = lax.conv_general_dilated(u, w[:, None, :].astype(u.dtype), window_strides=(1,),
                                   padding=[(CONV_K // 2, CONV_K // 2)],
                                   dimension_numbers=('NWC', 'WIO', 'NWC'), feature_group_count=c)
    return out + bias


def _ssd_scan(x, dt, a, bm, cm, h0):
    b, l, h, p = x.shape
    g, n = bm.shape[2], bm.shape[3]
    r = h // g
    q = math.gcd(l, SSD_CHUNK)
    nc = l // q
    la = (dt * a).reshape(b, nc, q, g, r)
    xdt = (x * dt[..., None]).reshape(b, nc, q, g, r, p)
    bm = bm.reshape(b, nc, q, g, n)
    cm = cm.reshape(b, nc, q, g, n)
    acum = jnp.cumsum(la, axis=2)
    causal = jnp.arange(q)[:, None] >= jnp.arange(q)[None, :]
    seg = acum[:, :, :, None] - acum[:, :, None, :]
    decay = jnp.exp(jnp.where(causal[:, :, None, None], seg, -jnp.inf))
    cb = jnp.einsum('bcign,bcjgn->bcijg', cm, bm)
    y_diag = jnp.einsum('bcijg,bcijgr,bcjgrp->bcigrp', cb, decay, xdt)
    to_end = jnp.exp(acum[:, :, -1:] - acum)
    states = jnp.einsum('bcjgn,bcjgr,bcjgrp->bcgrpn', bm, to_end, xdt)
    chunk_decay = jnp.exp(acum[:, :, -1])

    def step(hc, inp):
        s, dcy = inp
        return dcy[..., None, None] * hc + s, hc

    h_last, h_in = lax.scan(step, h0.reshape(b, g, r, p, n),
                            (jnp.moveaxis(states, 1, 0), jnp.moveaxis(chunk_decay, 1, 0)))
    h_in = jnp.moveaxis(h_in, 0, 1)
    y_off = jnp.einsum('bcign,bcgrpn,bcigr->bcigrp', cm, h_in, jnp.exp(acum))
    return (y_diag + y_off).reshape(b, l, h, p), h_last.reshape(b, h, p, n)


def _ssd_branch(z, xbc, dt_raw, conv_w, conv_b, dt_bias, a_log, d_skip, norm_g, h0):
    b, l, _ = z.shape
    f32 = jnp.float32
    xbc = jax.nn.silu(_centred_depthwise_conv(xbc, conv_w, conv_b)).astype(f32)
    xs = xbc[..., :DI_B].reshape(b, l, H_B, P_B)
    bm = xbc[..., DI_B:DI_B + G_B * N_B].reshape(b, l, G_B, N_B)
    cm = xbc[..., DI_B + G_B * N_B:].reshape(b, l, G_B, N_B)
    dt = jax.nn.softplus(dt_raw.astype(f32).reshape(b, l, 2, H_B) + dt_bias.astype(f32))
    a = -jnp.exp(a_log.astype(f32))
    h0 = h0.astype(f32)
    flip = lambda u: jnp.flip(u, axis=1)
    y_f, h_f = _ssd_scan(xs, dt[:, :, 0], a[0], bm, cm, h0[:, 0])
    y_b, h_b = _ssd_scan(flip(xs), flip(dt[:, :, 1]), a[1], flip(bm), flip(cm), h0[:, 1])
    y = y_f + flip(y_b) + xs * jnp.sum(d_skip.astype(f32), axis=0)[:, None]
    y = y.reshape(b, l, DI_B) * jax.nn.silu(z.astype(f32))
    y = _rmsnorm(y, norm_g).astype(z.dtype)
    return y, jnp.stack([h_f, h_b], axis=1).astype(z.dtype)


def _pre(x, cvec, norm_g, w_ada, b_ada, w_in):
    ada = (jax.nn.silu(cvec) @ w_ada + b_ada)[..., None, :]
    shift, scale, gate = jnp.split(ada, 3, axis=-1)
    hmod = _rmsnorm(x, norm_g) * (1.0 + scale) + shift
    parts = jnp.split(hmod @ w_in, np.cumsum(IN_SIZES)[:-1].tolist(), axis=-1)
    return parts, gate


def _post(x, gate, ya, ga, yb, yc, gc, merge_logits, w_br_a, w_br_b, w_br_c, w_out):
    ma, mb, mc = jnp.split(jax.nn.sigmoid(merge_logits), N_BRANCH, axis=-1)
    merged = (ma * ((ya * jax.nn.silu(ga)) @ w_br_a) + mb * (yb @ w_br_b)
              + mc * ((yc * jax.nn.silu(gc)) @ w_br_c))
    return x + gate * (merged @ w_out)


def _context_layer(x, c_ctx, lam_init, lw):
    (norm_g, w_ada, b_ada, w_in, lam_q1, lam_k1, lam_q2, lam_k2, subln_g, conv_w, conv_b,
     dt_bias, a_log, d_skip, ssd_norm_g, na_rpb, w_br_a, w_br_b, w_br_c, w_out) = lw
    b, l, _ = x.shape
    (qa, ka, va, ga, z, xbc, dt_raw, qc, kc, vc, gc, merge), gate = _pre(x, c_ctx, norm_g, w_ada, b_ada, w_in)
    qa = qa.reshape(b, l, H_A, 2, DH_A)
    ka = ka.reshape(b, l, H_A, 2, DH_A)
    va = va.reshape(b, l, H_A, 2 * DH_A)
    lam = _diff_lambda(lam_q1, lam_k1, lam_q2, lam_k2, lam_init)
    ya = _diff_post(_diff_attention(qa, ka, va, lam), subln_g, lam_init)
    h0 = jnp.zeros((b, 2, H_B, P_B, N_B), jnp.float32)
    yb, ssd_state = _ssd_branch(z, xbc, dt_raw, conv_w, conv_b, dt_bias, a_log, d_skip, ssd_norm_g, h0)
    qc, kc, vc = (u.reshape(b, l, H_C, DH_C) for u in (qc, kc, vc))
    yc = _softmax_attention(qc, kc, vc).reshape(b, l, W_C)
    x = _post(x, gate, ya, ga, yb, yc, gc, merge, w_br_a, w_br_b, w_br_c, w_out)
    return x, ka.reshape(b, l, H_A, 2 * DH_A), va, kc, vc, ssd_state


def _latent_layer(x, c, lam_init, ck_a, cv_a, ck_c, cv_c, h0, lw):
    (norm_g, w_ada, b_ada, w_in, lam_q1, lam_k1, lam_q2, lam_k2, subln_g, conv_w, conv_b,
     dt_bias, a_log, d_skip, ssd_norm_g, na_rpb, w_br_a, w_br_b, w_br_c, w_out) = lw
    b, l, _ = x.shape
    plen = ck_a.shape[1]
    (qa, ka, va, ga, z, xbc, dt_raw, qc, kc, vc, gc, merge), gate = _pre(x, c, norm_g, w_ada, b_ada, w_in)
    qa = _axial_rope(qa.reshape(b, l, H_A, 2, DH_A))
    ka = _axial_rope(ka.reshape(b, l, H_A, 2, DH_A))
    k_all = jnp.concatenate([ka, ck_a.reshape(b, plen, H_A, 2, DH_A)], axis=1)
    v_all = jnp.concatenate([va.reshape(b, l, H_A, 2 * DH_A), cv_a], axis=1)
    lam = _diff_lambda(lam_q1, lam_k1, lam_q2, lam_k2, lam_init)
    ya = _diff_post(_diff_attention(qa, k_all, v_all, lam), subln_g, lam_init)
    yb, _ = _ssd_branch(z, xbc, dt_raw, conv_w, conv_b, dt_bias, a_log, d_skip, ssd_norm_g, h0)
    qc, kc, vc = (u.reshape(b, l, H_C, DH_C) for u in (qc, kc, vc))
    yc = _neighborhood_attention(qc, kc, vc, ck_c, cv_c, na_rpb)
    return _post(x, gate, ya, ga, yb, yc, gc, merge, w_br_a, w_br_b, w_br_c, w_out)


def setup_inputs(seed: int = 0) -> dict:
    key = jax.random.key(seed)
    ks = iter(jax.random.split(key, 40))
    d = D_MODEL

    def nrm(shape, s):
        return jax.random.normal(next(ks), shape, jnp.float32) * s

    dt0 = jnp.exp(jax.random.uniform(next(ks), (DEPTH, 2, H_B), jnp.float32, math.log(1e-3), math.log(1e-1)))
    a0 = jax.random.uniform(next(ks), (DEPTH, 2, H_B), jnp.float32, 1.0, 16.0)
    return {
        'x_prompt': nrm((BATCH, SEQ, d), 1.0),
        'x_sample': nrm((DEC_BATCH, DEC_SEQ, d), 1.0),
        'cache_diff_k': nrm((DEC_BATCH, DEPTH, PAST_LEN, H_A, 2 * DH_A), 1.0),
        'cache_diff_v': nrm((DEC_BATCH, DEPTH, PAST_LEN, H_A, 2 * DH_A), 1.0),
        'cache_na_k': nrm((DEC_BATCH, DEPTH, PAST_LEN, H_C, DH_C), 1.0),
        'cache_na_v': nrm((DEC_BATCH, DEPTH, PAST_LEN, H_C, DH_C), 1.0),
        'state_ssd': nrm((DEC_BATCH, DEPTH, 2, H_B, P_B, N_B), 0.5),
        'c': nrm((DEC_BATCH, d), 1.0),
        'c_ctx': nrm((d,), 1.0),
        'norm_g': 1.0 + nrm((DEPTH, d), 0.01),
        'w_ada': nrm((DEPTH, d, 3 * d), 0.5 * d ** -0.5),
        'b_ada': nrm((DEPTH, 3 * d), 0.01),
        'w_in': nrm((DEPTH, d, IN_COLS), d ** -0.5),
        'lam_q1': nrm((DEPTH, DH_A), 0.1),
        'lam_k1': nrm((DEPTH, DH_A), 0.1),
        'lam_q2': nrm((DEPTH, DH_A), 0.1),
        'lam_k2': nrm((DEPTH, DH_A), 0.1),
        'diff_subln_g': 1.0 + nrm((DEPTH, 2 * DH_A), 0.01),
        'conv_w': nrm((DEPTH, CONV_K, CONV_DIM), CONV_K ** -0.5),
        'conv_b': nrm((DEPTH, CONV_DIM), 0.01),
        'dt_bias': dt0 + jnp.log(-jnp.expm1(-dt0)),
        'a_log': jnp.log(a0),
        'd_skip': 1.0 + nrm((DEPTH, 2, H_B), 0.1),
        'ssd_norm_g': 1.0 + nrm((DEPTH, DI_B), 0.01),
        'na_rpb': nrm((DEPTH, H_C, 2 * NA_KH - 1, 2 * NA_KW - 1), 0.02),
        'w_br_a': nrm((DEPTH, W_A, d), W_A ** -0.5),
        'w_br_b': nrm((DEPTH, DI_B, d), DI_B ** -0.5),
        'w_br_c': nrm((DEPTH, W_C, d), W_C ** -0.5),
        'w_out': nrm((DEPTH, d, d), d ** -0.5),
        'final_g': 1.0 + nrm((d,), 0.01),
    }


def reference(x_prompt, x_sample, cache_diff_k, cache_diff_v, cache_na_k, cache_na_v, state_ssd,
              c, c_ctx, norm_g, w_ada, b_ada, w_in, lam_q1, lam_k1, lam_q2, lam_k2, diff_subln_g,
              conv_w, conv_b, dt_bias, a_log, d_skip, ssd_norm_g, na_rpb, w_br_a, w_br_b, w_br_c,
              w_out, final_g):
    xp, xs = x_prompt, x_sample
    new_k_a, new_v_a, new_k_c, new_v_c, new_ssd = [], [], [], [], []
    for li in range(DEPTH):
        lam_init = 0.8 - 0.6 * math.exp(-0.3 * li)
        lw = (norm_g[li], w_ada[li], b_ada[li], w_in[li], lam_q1[li], lam_k1[li], lam_q2[li], lam_k2[li],
              diff_subln_g[li], conv_w[li], conv_b[li], dt_bias[li], a_log[li], d_skip[li], ssd_norm_g[li],
              na_rpb[li], w_br_a[li], w_br_b[li], w_br_c[li], w_out[li])
        xp, ka, va, kc, vc, hs = _context_layer(xp, c_ctx, lam_init, lw)
        new_k_a.append(ka)
        new_v_a.append(va)
        new_k_c.append(kc)
        new_v_c.append(vc)
        new_ssd.append(hs)
        xs = _latent_layer(xs, c, lam_init, cache_diff_k[:, li], cache_diff_v[:, li],
                           cache_na_k[:, li], cache_na_v[:, li], state_ssd[:, li], lw)
    y_prompt = _rmsnorm(xp, final_g)
    y_sample = _rmsnorm(xs, final_g)
    return (y_prompt, y_sample, jnp.stack(new_k_a, axis=1), jnp.stack(new_v_a, axis=1),
            jnp.stack(new_k_c, axis=1), jnp.stack(new_v_c, axis=1), jnp.stack(new_ssd, axis=1))
```

```cpp
#include <hip/hip_runtime.h>
#include <hip/hip_cooperative_groups.h>
#include <stdint.h>
#include <stdio.h>
namespace cg = cooperative_groups;

#ifndef MULTI_LAUNCH
#define MULTI_LAUNCH 0
#endif

#define DI __device__ __forceinline__
typedef unsigned short bf16_t;
typedef short bf16x8 __attribute__((ext_vector_type(8)));
typedef float f32x4 __attribute__((ext_vector_type(4)));
typedef unsigned u32x4 __attribute__((ext_vector_type(4)));
typedef unsigned u32x2 __attribute__((ext_vector_type(2)));

constexpr int DM = 1024;
constexpr int NCTX = 8192;
constexpr int NLAT = 2048;
constexpr int MTOK = NCTX + NLAT;
constexpr int INC = 8464;
constexpr int NPAD = 8576;
constexpr int LDP = 7424;
constexpr int PC_QA = 0, PC_KA = 512, PC_GA = 1024, PC_Z = 1536, PC_XBC = 2048, PC_QC = 2816, PC_KC = 3328, PC_GC = 3840, PC_MG = 4352;
constexpr float EPS = 1e-6f;

constexpr size_t O_YP = 0;
constexpr size_t O_DK = 10485760;
constexpr size_t O_DV = 18874368;
constexpr size_t O_NK = 27262976;
constexpr size_t O_NV = 35651584;
constexpr size_t O_SS = 44040192;

constexpr size_t W_WTIN = 0;
constexpr size_t W_WTBR = W_WTIN + (size_t)2 * NPAD * 1024 * 2;
constexpr size_t W_WTOUT = W_WTBR + (size_t)2 * 3 * 1024 * 512 * 2;
constexpr size_t W_CKA = W_WTOUT + (size_t)2 * 1024 * 1024 * 2;
constexpr size_t W_CVTA = W_CKA + 2097152;
constexpr size_t W_CKC = W_CVTA + 2097152;
constexpr size_t W_CVTC = W_CKC + 2097152;
constexpr size_t W_ADA = W_CVTC + 2097152;
constexpr size_t W_ROPE = W_ADA + 73728;
constexpr size_t W_LAM = W_ROPE + 8192;
constexpr size_t W_PARTS = W_LAM + 256;
constexpr size_t W_VAT = W_PARTS + (size_t)MTOK * LDP * 2;
constexpr size_t W_VCT = W_VAT + (size_t)512 * MTOK * 2;
constexpr size_t W_DT = W_VCT + (size_t)512 * MTOK * 2;
constexpr size_t W_HMOD = W_DT + (size_t)MTOK * 16 * 4;
constexpr size_t W_YBF = W_HMOD + (size_t)MTOK * 1024 * 2;
constexpr size_t W_YBB = W_YBF + (size_t)MTOK * 512 * 2;
constexpr size_t W_BAR = W_YBB + (size_t)MTOK * 512 * 2;
constexpr size_t W_EA = W_BAR + 16384;
constexpr size_t W_CC = W_EA + (size_t)MTOK * 16 * 4;
constexpr size_t W_RSTD = W_CC + (size_t)MTOK * 128 * 2;
constexpr size_t W_END = W_RSTD + (size_t)MTOK * 4;

constexpr int SMEM_BYTES = 73728;
constexpr int LS = 72;

struct Params {
  const float *x_prompt, *x_sample, *cache_dk, *cache_dv, *cache_nk, *cache_nv, *state_ssd, *cvec, *c_ctx;
  const float *norm_g, *w_ada, *b_ada, *w_in, *lam_q1, *lam_k1, *lam_q2, *lam_k2, *subln_g, *conv_w, *conv_b;
  const float *dt_bias, *a_log, *d_skip, *ssd_norm_g, *na_rpb, *w_br_a, *w_br_b, *w_br_c, *w_out, *final_g;
  float* out;
  char* ws;
};

DI bf16_t f2bf(float x) { unsigned u = __float_as_uint(x); u += 0x7fffu + ((u >> 16) & 1u); return (bf16_t)(u >> 16); }
DI float bf2f(bf16_t h) { return __uint_as_float(((unsigned)h) << 16); }
DI unsigned pack2(float a, float b) { return (unsigned)f2bf(a) | ((unsigned)f2bf(b) << 16); }
DI float bflo(unsigned u) { return __uint_as_float(u << 16); }
DI float bfhi(unsigned u) { return __uint_as_float(u & 0xffff0000u); }
DI float siluf(float x) { return x / (1.f + __expf(-x)); }
DI float sigmf(float x) { return 1.f / (1.f + __expf(-x)); }
DI float wave_sum(float v) {
#pragma unroll
  for (int o = 32; o > 0; o >>= 1) v += __shfl_xor(v, o);
  return v;
}
DI void unpack8(const u32x4& v, float* f) {
  f[0] = bflo(v.x); f[1] = bfhi(v.x); f[2] = bflo(v.y); f[3] = bfhi(v.y);
  f[4] = bflo(v.z); f[5] = bfhi(v.z); f[6] = bflo(v.w); f[7] = bfhi(v.w);
}
DI f32x4 mfma16(bf16x8 a, bf16x8 b, f32x4 c) { return __builtin_amdgcn_mfma_f32_16x16x32_bf16(a, b, c, 0, 0, 0); }
DI bf16x8 lds_frag(const bf16_t* s, int row, int k) { return *(const bf16x8*)(s + row * LS + k); }
DI int get_tid() { int t = threadIdx.x; asm volatile("" : "+v"(t)); return t; }
DI float lam_init_of(int layer) { return layer == 0 ? 0.2f : (0.8f - 0.6f * 0.7408182206817179f); }

DI void transpose_tile(const float* __restrict__ src, int ld, int R0, int C0, int Cmax, bf16_t* __restrict__ dst, int ld_dst,
                       bool perm_in, float* tile) {
  const int tid = get_tid();
#pragma unroll
  for (int i = 0; i < 4; ++i) {
    int idx = tid + 256 * i, r = idx >> 4, c4 = (idx & 15) * 4;
    float4 v = make_float4(0.f, 0.f, 0.f, 0.f);
    if (C0 + c4 < Cmax) v = *(const float4*)(src + (size_t)(R0 + r) * ld + C0 + c4);
    float* t = tile + r * 65 + c4;
    t[0] = v.x; t[1] = v.y; t[2] = v.z; t[3] = v.w;
  }
  __syncthreads();
#pragma unroll
  for (int i = 0; i < 2; ++i) {
    int idx = tid + 256 * i, cc = idx >> 3, kc = (idx & 7) * 8;
    int n = C0 + cc;
    if (n < Cmax) {
      int nrow = n;
      if (perm_in) nrow = (n < 3328) ? n : (n < 3344 ? 8448 + (n - 3328) : n - 16);
      u32x4 w;
      w.x = pack2(tile[(kc + 0) * 65 + cc], tile[(kc + 1) * 65 + cc]);
      w.y = pack2(tile[(kc + 2) * 65 + cc], tile[(kc + 3) * 65 + cc]);
      w.z = pack2(tile[(kc + 4) * 65 + cc], tile[(kc + 5) * 65 + cc]);
      w.w = pack2(tile[(kc + 6) * 65 + cc], tile[(kc + 7) * 65 + cc]);
      *(u32x4*)(dst + (size_t)nrow * ld_dst + R0 + kc) = w;
    }
  }
  __syncthreads();
}

constexpr int J_ADA = 192;
constexpr int J_WIN = J_ADA + 2 * 16 * 133;
constexpr int J_WBR = J_WIN + 768;
constexpr int J_WOUT = J_WBR + 512;
constexpr int J_CV = J_WOUT + 512;
constexpr int J_CK = J_CV + 512;
constexpr int J_MISC = J_CK + 1;

constexpr int J_DEF0 = J_ADA + 16 * 133, J_DEF1 = J_WOUT, N_DEF = J_DEF1 - J_DEF0;
__device__ __forceinline__ void phase_prep(const Params& p, char* smem, int mode, int first, int stride, int lo = 0, int hi = 1 << 30) {
  const int tid = get_tid();
  float* fs = (float*)smem;
  const int njobs = min(hi, mode == 0 ? J_MISC - N_DEF : N_DEF);
  for (int idx = lo + first; idx < njobs; idx += stride) {
    const int job = mode == 0 ? (idx < J_DEF0 ? idx : idx + N_DEF) : J_DEF0 + idx;
    if (job < J_ADA) {
      const int l = job / 96, jg = job % 96;
      float* sv = fs;
      float* red = fs + 3072;
      for (int i = tid; i < 3072; i += 256) {
        int v = i >> 10, k = i & 1023;
        float x = (v == 0) ? p.c_ctx[k] : p.cvec[(v - 1) * 1024 + k];
        sv[i] = siluf(x);
      }
      __syncthreads();
      const int kq = tid >> 5, jj = tid & 31;
      const float* w = p.w_ada + (size_t)l * 1024 * 3072 + jg * 32 + jj;
      float a0 = 0.f, a1 = 0.f, a2 = 0.f;
#pragma unroll 8
      for (int k = kq * 128; k < kq * 128 + 128; ++k) {
        float wv = w[(size_t)k * 3072];
        a0 += sv[k] * wv; a1 += sv[1024 + k] * wv; a2 += sv[2048 + k] * wv;
      }
      red[(kq * 3 + 0) * 32 + jj] = a0; red[(kq * 3 + 1) * 32 + jj] = a1; red[(kq * 3 + 2) * 32 + jj] = a2;
      __syncthreads();
      if (tid < 96) {
        int v = tid >> 5, j2 = tid & 31;
        float s = 0.f;
#pragma unroll
        for (int q = 0; q < 8; ++q) s += red[(q * 3 + v) * 32 + j2];
        int col = jg * 32 + j2;
        s += p.b_ada[l * 3072 + col];
        ((float*)(p.ws + W_ADA))[(l * 3 + v) * 3072 + col] = s;
      }
      __syncthreads();
    } else if (job < J_WIN) {
      int j = job - J_ADA; int l = j / (16 * 133); j %= (16 * 133);
      int rt = j / 133, ct = j % 133;
      transpose_tile(p.w_in + (size_t)l * 1024 * INC, INC, rt * 64, ct * 64, INC,
                     (bf16_t*)(p.ws + W_WTIN) + (size_t)l * NPAD * 1024, 1024, true, fs);
    } else if (job < J_WBR) {
      int j = job - J_WIN; int lb = j / 128; j %= 128;
      int l = lb / 3, br = lb % 3;
      int rt = j / 16, ct = j % 16;
      const float* src = (br == 0 ? p.w_br_a : (br == 1 ? p.w_br_b : p.w_br_c)) + (size_t)l * 512 * 1024;
      transpose_tile(src, 1024, rt * 64, ct * 64, 1024, (bf16_t*)(p.ws + W_WTBR) + (size_t)lb * 1024 * 512, 512, false, fs);
    } else if (job < J_WOUT) {
      int j = job - J_WBR; int l = j / 256; j %= 256;
      int rt = j / 16, ct = j % 16;
      transpose_tile(p.w_out + (size_t)l * 1024 * 1024, 1024, rt * 64, ct * 64, 1024,
                     (bf16_t*)(p.ws + W_WTOUT) + (size_t)l * 1024 * 1024, 1024, false, fs);
    } else if (job < J_CV) {
      int j = job - J_WOUT; int which = j / 256; j %= 256;
      int bl = j / 64; j %= 64;
      int rt = j / 8, ct = j % 8;
      const float* src = (which == 0 ? p.cache_dv : p.cache_nv) + (size_t)bl * 512 * 512;
      bf16_t* dst = (bf16_t*)(p.ws + (which == 0 ? W_CVTA : W_CVTC)) + (size_t)bl * 512 * 512;
      transpose_tile(src, 512, rt * 64, ct * 64, 512, dst, 512, false, fs);
    } else if (job < J_CK) {
      int j = job - J_CV; int which = j / 256; j %= 256;
      const float* src = (which == 0 ? p.cache_dk : p.cache_nk) + (size_t)j * 4096;
      bf16_t* dst = (bf16_t*)(p.ws + (which == 0 ? W_CKA : W_CKC)) + (size_t)j * 4096;
#pragma unroll
      for (int i = 0; i < 2; ++i) {
        int e = (tid + 256 * i) * 8;
        float4 a = *(const float4*)(src + e), b = *(const float4*)(src + e + 4);
        u32x4 w; w.x = pack2(a.x, a.y); w.y = pack2(a.z, a.w); w.z = pack2(b.x, b.y); w.w = pack2(b.z, b.w);
        *(u32x4*)(dst + e) = w;
      }
    } else {
      float2* rope = (float2*)(p.ws + W_ROPE);
      for (int i = tid; i < 1024; i += 256) {
        int pos = i >> 4, fi = i & 15;
        float inv = exp2f(-(float)fi * (13.287712379549449f / 16.f));
        float ang = (float)pos * inv;
        rope[i] = make_float2(cosf(ang), sinf(ang));
      }
      if (tid < 2) {
        int l = tid;
        float s1 = 0.f, s2 = 0.f;
        for (int k = 0; k < 64; ++k) {
          s1 += p.lam_q1[l * 64 + k] * p.lam_k1[l * 64 + k];
          s2 += p.lam_q2[l * 64 + k] * p.lam_k2[l * 64 + k];
        }
        ((float*)(p.ws + W_LAM))[l] = expf(s1) - expf(s2) + lam_init_of(l);
      }
    }
  }
}

__device__ __forceinline__ void phase_hmod(const Params& p, int layer) {
  const int lane = get_tid() & 63, wave = __builtin_amdgcn_readfirstlane(get_tid() >> 6);
  const int gw = blockIdx.x * 4 + wave, nw = gridDim.x * 4;
  bf16_t* hm = (bf16_t*)(p.ws + W_HMOD);
  const float* ng = p.norm_g + layer * 1024;
  f32x4 xn[4];
  {
    const int row = min(gw, MTOK - 1);
    const float* x = (layer == 0) ? (row < NCTX ? p.x_prompt + (size_t)row * 1024 : p.x_sample + (size_t)(row - NCTX) * 1024)
                                  : p.out + (size_t)row * 1024;
#pragma unroll
    for (int i = 0; i < 4; ++i) xn[i] = *(const f32x4*)(x + (i * 64 + lane) * 4);
  }
  for (int row = gw; row < MTOK; row += nw) {
    const int v = row < NCTX ? 0 : 1 + ((row - NCTX) >> 10);
    const float* ada = (const float*)(p.ws + W_ADA) + (layer * 3 + v) * 3072;
    float4 xv[4];
    float ss = 0.f;
#pragma unroll
    for (int i = 0; i < 4; ++i) {
      xv[i] = make_float4(xn[i][0], xn[i][1], xn[i][2], xn[i][3]);
      ss += xv[i].x * xv[i].x + xv[i].y * xv[i].y + xv[i].z * xv[i].z + xv[i].w * xv[i].w;
    }
    {
      const int rn = min(row + nw, MTOK - 1);
      const float* x2 = (layer == 0) ? (rn < NCTX ? p.x_prompt + (size_t)rn * 1024 : p.x_sample + (size_t)(rn - NCTX) * 1024)
                                     : p.out + (size_t)rn * 1024;
#pragma unroll
      for (int i = 0; i < 4; ++i) xn[i] = *(const f32x4*)(x2 + (i * 64 + lane) * 4);
    }
    ss = wave_sum(ss);
    const float rstd = rsqrtf(ss * (1.f / 1024.f) + EPS);
#pragma unroll
    for (int i = 0; i < 4; ++i) {
      int col = (i * 64 + lane) * 4;
      float4 g = *(const float4*)(ng + col);
      float4 sh = *(const float4*)(ada + col);
      float4 sc = *(const float4*)(ada + 1024 + col);
      float h0 = xv[i].x * rstd * g.x * (1.f + sc.x) + sh.x;
      float h1 = xv[i].y * rstd * g.y * (1.f + sc.y) + sh.y;
      float h2 = xv[i].z * rstd * g.z * (1.f + sc.z) + sh.z;
      float h3 = xv[i].w * rstd * g.w * (1.f + sc.w) + sh.w;
      u32x2 w; w.x = pack2(h0, h1); w.y = pack2(h2, h3);
      *(u32x2*)(hm + (size_t)row * 1024 + col) = w;
    }
  }
}

template <int MT, int NT, int DEPTH, bool PERMB = false>
DI void gemm_mainloop(const bf16_t* __restrict__ Ag, int lda, const bf16_t* __restrict__ Bg, int ldb, int K,
                      f32x4 (&acc)[MT][NT], bf16_t* sA, bf16_t* sB) {
  const int tid = get_tid(), lane = tid & 63, wave = __builtin_amdgcn_readfirstlane(tid >> 6), wm = wave >> 1, wn = wave & 1, c = lane & 15, g = lane >> 4;
  u32x4 ra0[MT], rb0[NT], ra1[MT], rb1[NT];
  const int lr = tid >> 3, lk = (tid & 7) * 8;
  const int lrb = PERMB ? 16 * ((lr >> 2) & 1) + 4 * ((lr >> 3) & 3) + (lr & 3) : lr;
  const bf16_t* ap = Ag + (size_t)lr * lda + lk;
  const bf16_t* bp = Bg + (size_t)lr * ldb + lk;
#define GLOAD(RA, RB, K0) { _Pragma("unroll") for (int i = 0; i < MT; ++i) RA[i] = *(const u32x4*)(ap + (size_t)(32 * i) * lda + (K0)); \
                            _Pragma("unroll") for (int i = 0; i < NT; ++i) RB[i] = *(const u32x4*)(bp + (size_t)(32 * i) * ldb + (K0)); }
#define LSTORE(RA, RB) { _Pragma("unroll") for (int i = 0; i < MT; ++i) *(u32x4*)(sA + (lr + 32 * i) * LS + lk) = RA[i]; \
                         _Pragma("unroll") for (int i = 0; i < NT; ++i) *(u32x4*)(sB + (lrb + 32 * i) * LS + lk) = RB[i]; }
#define COMPUTE() { _Pragma("unroll") for (int ks = 0; ks < 2; ++ks) { bf16x8 xf[MT], wf[NT]; \
      _Pragma("unroll") for (int t = 0; t < MT; ++t) xf[t] = lds_frag(sA, 16 * MT * wm + 16 * t + c, 32 * ks + 8 * g); \
      _Pragma("unroll") for (int t = 0; t < NT; ++t) wf[t] = lds_frag(sB, 16 * NT * wn + 16 * t + c, 32 * ks + 8 * g); \
      _Pragma("unroll") for (int mt = 0; mt < MT; ++mt) _Pragma("unroll") for (int nt = 0; nt < NT; ++nt) acc[mt][nt] = mfma16(wf[nt], xf[mt], acc[mt][nt]); } }
  const int nk = K >> 6;
  if (DEPTH == 2) {
    GLOAD(ra0, rb0, 0);
    GLOAD(ra1, rb1, 64);
    for (int kt = 0; kt < nk; kt += 2) {
      __syncthreads();
      LSTORE(ra0, rb0);
      __syncthreads();
      if (kt + 2 < nk) GLOAD(ra0, rb0, (kt + 2) << 6);
      COMPUTE();
      __syncthreads();
      LSTORE(ra1, rb1);
      __syncthreads();
      if (kt + 3 < nk) GLOAD(ra1, rb1, (kt + 3) << 6);
      COMPUTE();
    }
  } else {
    GLOAD(ra0, rb0, 0);
    for (int kt = 0; kt < nk; ++kt) {
      __syncthreads();
      LSTORE(ra0, rb0);
      __syncthreads();
      if (kt + 1 < nk) GLOAD(ra0, rb0, (kt + 1) << 6);
      COMPUTE();
    }
  }
#undef GLOAD
#undef LSTORE
#undef COMPUTE
}

template <int MT, int NT>
DI void zero_acc(f32x4 (&acc)[MT][NT]) {
#pragma unroll
  for (int a = 0; a < MT; ++a)
#pragma unroll
    for (int b = 0; b < NT; ++b) acc[a][b] = (f32x4){0.f, 0.f, 0.f, 0.f};
}

DI void lds_read_frags(bf16x8 (&x)[4], bf16x8 (&w)[4], unsigned aA, unsigned aB, int ks) {
  if (ks == 0)
    asm volatile("ds_read_b128 %0, %8\n\tds_read_b128 %1, %8 offset:2304\n\tds_read_b128 %2, %8 offset:4608\n\tds_read_b128 %3, %8 offset:6912\n\t"
                 "ds_read_b128 %4, %9\n\tds_read_b128 %5, %9 offset:2304\n\tds_read_b128 %6, %9 offset:4608\n\tds_read_b128 %7, %9 offset:6912\n\t"
                 "s_waitcnt lgkmcnt(0)"
                 : "=&v"(x[0]), "=&v"(x[1]), "=&v"(x[2]), "=&v"(x[3]), "=&v"(w[0]), "=&v"(w[1]), "=&v"(w[2]), "=&v"(w[3])
                 : "v"(aA), "v"(aB) : "memory");
  else
    asm volatile("ds_read_b128 %0, %8 offset:64\n\tds_read_b128 %1, %8 offset:2368\n\tds_read_b128 %2, %8 offset:4672\n\tds_read_b128 %3, %8 offset:6976\n\t"
                 "ds_read_b128 %4, %9 offset:64\n\tds_read_b128 %5, %9 offset:2368\n\tds_read_b128 %6, %9 offset:4672\n\tds_read_b128 %7, %9 offset:6976\n\t"
                 "s_waitcnt lgkmcnt(0)"
                 : "=&v"(x[0]), "=&v"(x[1]), "=&v"(x[2]), "=&v"(x[3]), "=&v"(w[0]), "=&v"(w[1]), "=&v"(w[2]), "=&v"(w[3])
                 : "v"(aA), "v"(aB) : "memory");
}
DI void lds_read_frags(bf16x8 (&x)[5], bf16x8 (&w)[2], unsigned aA, unsigned aB, int ks) {
  if (ks == 0)
    asm volatile("ds_read_b128 %0, %7\n\tds_read_b128 %1, %7 offset:2304\n\tds_read_b128 %2, %7 offset:4608\n\tds_read_b128 %3, %7 offset:6912\n\tds_read_b128 %4, %7 offset:9216\n\t"
                 "ds_read_b128 %5, %8\n\tds_read_b128 %6, %8 offset:2304\n\t"
                 "s_waitcnt lgkmcnt(0)"
                 : "=&v"(x[0]), "=&v"(x[1]), "=&v"(x[2]), "=&v"(x[3]), "=&v"(x[4]), "=&v"(w[0]), "=&v"(w[1])
                 : "v"(aA), "v"(aB) : "memory");
  else
    asm volatile("ds_read_b128 %0, %7 offset:64\n\tds_read_b128 %1, %7 offset:2368\n\tds_read_b128 %2, %7 offset:4672\n\tds_read_b128 %3, %7 offset:6976\n\tds_read_b128 %4, %7 offset:9280\n\t"
                 "ds_read_b128 %5, %8 offset:64\n\tds_read_b128 %6, %8 offset:2368\n\t"
                 "s_waitcnt lgkmcnt(0)"
                 : "=&v"(x[0]), "=&v"(x[1]), "=&v"(x[2]), "=&v"(x[3]), "=&v"(x[4]), "=&v"(w[0]), "=&v"(w[1])
                 : "v"(aA), "v"(aB) : "memory");
}

DI void lds_issue_frags1(bf16x8 (&x)[4], bf16x8 (&w)[4], unsigned aA, unsigned aB) {
  asm volatile("ds_read_b128 %0, %8 offset:64\n\tds_read_b128 %1, %8 offset:2368\n\tds_read_b128 %2, %8 offset:4672\n\tds_read_b128 %3, %8 offset:6976\n\t"
               "ds_read_b128 %4, %9 offset:64\n\tds_read_b128 %5, %9 offset:2368\n\tds_read_b128 %6, %9 offset:4672\n\tds_read_b128 %7, %9 offset:6976"
               : "=&v"(x[0]), "=&v"(x[1]), "=&v"(x[2]), "=&v"(x[3]), "=&v"(w[0]), "=&v"(w[1]), "=&v"(w[2]), "=&v"(w[3])
               : "v"(aA), "v"(aB) : "memory");
}
DI void lds_wait_frags(bf16x8 (&x)[4], bf16x8 (&w)[4], f32x4& a0, f32x4& a1, f32x4& a2, f32x4& a3) {
  asm volatile("s_waitcnt lgkmcnt(0)"
               : "+v"(x[0]), "+v"(x[1]), "+v"(x[2]), "+v"(x[3]), "+v"(w[0]), "+v"(w[1]), "+v"(w[2]), "+v"(w[3]),
                 "+v"(a0), "+v"(a1), "+v"(a2), "+v"(a3) :: "memory");
}
DI void lds_issue_frags1(bf16x8 (&x)[5], bf16x8 (&w)[2], unsigned aA, unsigned aB) { lds_read_frags(x, w, aA, aB, 1); }
DI void lds_wait_frags(bf16x8 (&x)[5], bf16x8 (&w)[2], f32x4& a0, f32x4& a1, f32x4& a2, f32x4& a3) {}

template <int MT, int NT, bool PERMB = false>
DI void gemm_mainloop_dma(const bf16_t* __restrict__ Ag, int lda, const bf16_t* __restrict__ Bg, int ldb, int K,
                          f32x4 (&acc)[MT][NT], char* smem) {
  constexpr int RA = 32 * MT, RB = 32 * NT, ROWS = RA + RB, NCH = ROWS * 9, NI = (NCH + 255) / 256, BUF = NI * 4096;
  static_assert(2 * BUF <= SMEM_BYTES, "LDS");
  const int tid = get_tid(), lane = tid & 63, wave = __builtin_amdgcn_readfirstlane(tid >> 6), wm = wave >> 1, wn = wave & 1, c = lane & 15, g = lane >> 4;
  const bf16_t* src[NI];
#pragma unroll
  for (int i = 0; i < NI; ++i) {
    const int q = tid + 256 * i;
    int row = q / 9, cc = q - row * 9;
    row = min(row, ROWS - 1); cc = min(cc, 7);
    int rb = row - RA;
    if (PERMB) { const int t = (rb >> 4) & 3, c4 = rb & 15; rb = (rb & ~63) + 32 * (t >> 1) + 8 * (c4 >> 2) + 4 * (t & 1) + (c4 & 3); }
    src[i] = (row < RA ? Ag + (size_t)row * lda : Bg + (size_t)rb * ldb) + cc * 8;
  }
#define DMA_ISSUE(KT, BUFI) { _Pragma("unroll") for (int i = 0; i < NI; ++i) \
    __builtin_amdgcn_global_load_lds((const unsigned*)(src[i] + ((KT) << 6)), (unsigned*)(smem + (BUFI) * BUF + (tid + 256 * i) * 16), 16, 0, 0); }
  const int nk = K >> 6;
  const unsigned ldsA = (unsigned)(size_t)smem + (unsigned)((16 * MT * wm + c) * (LS * 2) + 16 * g);
  const unsigned ldsB = (unsigned)(size_t)smem + (unsigned)((RA + 16 * NT * wn + c) * (LS * 2) + 16 * g);
  __syncthreads();
  DMA_ISSUE(0, 0);
  asm volatile("s_waitcnt vmcnt(0)" ::: "memory");
  __syncthreads();
  for (int kt = 0; kt < nk; ++kt) {
    const int cur = kt & 1;
    if (kt + 1 < nk) DMA_ISSUE(kt + 1, cur ^ 1);
    const unsigned aA = ldsA + cur * BUF, aB = ldsB + cur * BUF;
    {
      bf16x8 xf[MT], wf[NT], xg[MT], wg[NT];
      lds_read_frags(xf, wf, aA, aB, 0);
      lds_issue_frags1(xg, wg, aA, aB);
#pragma unroll
      for (int mt = 0; mt < MT; ++mt)
#pragma unroll
        for (int nt = 0; nt < NT; ++nt) acc[mt][nt] = mfma16(wf[nt], xf[mt], acc[mt][nt]);
      lds_wait_frags(xg, wg, acc[MT - 1][0], acc[MT - 1][1], acc[MT - 1][NT - 2], acc[MT - 1][NT - 1]);
#pragma unroll
      for (int mt = 0; mt < MT; ++mt)
#pragma unroll
        for (int nt = 0; nt < NT; ++nt) acc[mt][nt] = mfma16(wg[nt], xg[mt], acc[mt][nt]);
    }
    asm volatile("s_waitcnt vmcnt(0)" : "+v"(acc[0][0]), "+v"(acc[0][NT - 1]), "+v"(acc[MT - 1][0]), "+v"(acc[MT - 1][NT - 1]) :: "memory");
    __syncthreads();
  }
#undef DMA_ISSUE
}

DI void lds_read_frags_sw(bf16x8 (&x)[5], bf16x8 (&w)[4], unsigned aA, unsigned aB) {
  asm volatile("ds_read_b128 %0, %9\n\tds_read_b128 %1, %9 offset:2048\n\tds_read_b128 %2, %9 offset:4096\n\tds_read_b128 %3, %9 offset:6144\n\tds_read_b128 %4, %9 offset:8192\n\t"
               "ds_read_b128 %5, %10\n\tds_read_b128 %6, %10 offset:2048\n\tds_read_b128 %7, %10 offset:4096\n\tds_read_b128 %8, %10 offset:6144\n\t"
               "s_waitcnt lgkmcnt(0)"
               : "=&v"(x[0]), "=&v"(x[1]), "=&v"(x[2]), "=&v"(x[3]), "=&v"(x[4]), "=&v"(w[0]), "=&v"(w[1]), "=&v"(w[2]), "=&v"(w[3])
               : "v"(aA), "v"(aB) : "memory");
}
DI void lds_read_frags_sw(bf16x8 (&x)[5], bf16x8 (&w)[2], unsigned aA, unsigned aB) {
  asm volatile("ds_read_b128 %0, %7\n\tds_read_b128 %1, %7 offset:2048\n\tds_read_b128 %2, %7 offset:4096\n\tds_read_b128 %3, %7 offset:6144\n\tds_read_b128 %4, %7 offset:8192\n\t"
               "ds_read_b128 %5, %8\n\tds_read_b128 %6, %8 offset:2048\n\t"
               "s_waitcnt lgkmcnt(0)"
               : "=&v"(x[0]), "=&v"(x[1]), "=&v"(x[2]), "=&v"(x[3]), "=&v"(x[4]), "=&v"(w[0]), "=&v"(w[1])
               : "v"(aA), "v"(aB) : "memory");
}
template <bool PERMB, int NT = 4>
DI void gemm_mainloop_dma_sw(const bf16_t* __restrict__ Ag, int lda, const bf16_t* __restrict__ Bg, int ldb, int K,
                             f32x4 (&acc)[5][NT], char* smem) {
  constexpr int MT = 5, RA = 32 * MT, RB = 32 * NT, ROWS = RA + RB, NI = ROWS * 8 / 256, BUF = ROWS * 128;
  static_assert(ROWS * 8 % 256 == 0 && 2 * BUF <= SMEM_BYTES, "LDS");
  const int tid = get_tid(), lane = tid & 63, wave = __builtin_amdgcn_readfirstlane(tid >> 6), wm = wave >> 1, wn = wave & 1, c = lane & 15, g = lane >> 4;
  const bf16_t* src[NI];
#pragma unroll
  for (int i = 0; i < NI; ++i) {
    const int q = tid + 256 * i;
    const int row = q >> 3, x = (q & 7) ^ ((row >> 1) & 7);
    int rb = row - RA;
    if (PERMB && NT == 4) { const int t = (rb >> 4) & 3, c4 = rb & 15; rb = (rb & ~63) + 32 * (t >> 1) + 8 * (c4 >> 2) + 4 * (t & 1) + (c4 & 3); }
    if (PERMB && NT == 2) { const int t = (rb >> 4) & 1, c4 = rb & 15; rb = (rb & ~31) + 8 * (c4 >> 2) + 4 * t + (c4 & 3); }
    src[i] = (row < RA ? Ag + (size_t)row * lda : Bg + (size_t)rb * ldb) + x * 8;
  }
#define DMA_ISSUE(KT, BUFI) { _Pragma("unroll") for (int i = 0; i < NI; ++i) \
    __builtin_amdgcn_global_load_lds((const unsigned*)(src[i] + ((KT) << 6)), (unsigned*)(smem + (BUFI) * BUF + (tid + 256 * i) * 16), 16, 0, 0); }
  const int nk = K >> 6;
  const unsigned f = (unsigned)((c >> 1) & 7);
  const unsigned off0 = ((unsigned)g ^ f) * 16u, off1 = off0 ^ 64u;
  const unsigned rowA = (unsigned)(size_t)smem + (unsigned)((16 * MT * wm + c) * 128);
  const unsigned rowB = (unsigned)(size_t)smem + (unsigned)((RA + 16 * NT * wn + c) * 128);
  __syncthreads();
  DMA_ISSUE(0, 0);
  asm volatile("s_waitcnt vmcnt(0)" ::: "memory");
  __syncthreads();
  for (int kt = 0; kt < nk; ++kt) {
    const int cur = kt & 1;
    if (kt + 1 < nk) DMA_ISSUE(kt + 1, cur ^ 1);
    {
      bf16x8 xf[MT], wf[NT];
      lds_read_frags_sw(xf, wf, rowA + cur * BUF + off0, rowB + cur * BUF + off0);
#pragma unroll
      for (int mt = 0; mt < MT; ++mt)
#pragma unroll
        for (int nt = 0; nt < NT; ++nt) acc[mt][nt] = mfma16(wf[nt], xf[mt], acc[mt][nt]);
    }
    {
      bf16x8 xf[MT], wf[NT];
      lds_read_frags_sw(xf, wf, rowA + cur * BUF + off1, rowB + cur * BUF + off1);
#pragma unroll
      for (int mt = 0; mt < MT; ++mt)
#pragma unroll
        for (int nt = 0; nt < NT; ++nt) acc[mt][nt] = mfma16(wf[nt], xf[mt], acc[mt][nt]);
    }
    asm volatile("s_waitcnt vmcnt(0)" : "+v"(acc[0][0]), "+v"(acc[0][NT - 1]), "+v"(acc[MT - 1][0]), "+v"(acc[MT - 1][NT - 1]) :: "memory");
    __syncthreads();
  }
#undef DMA_ISSUE
}

DI void lds_read_frags_sw(bf16x8 (&x)[4], bf16x8 (&w)[4], unsigned aA, unsigned aB) {
  asm volatile("ds_read_b128 %0, %8\n\tds_read_b128 %1, %8 offset:2048\n\tds_read_b128 %2, %8 offset:4096\n\tds_read_b128 %3, %8 offset:6144\n\t"
               "ds_read_b128 %4, %9\n\tds_read_b128 %5, %9 offset:2048\n\tds_read_b128 %6, %9 offset:4096\n\tds_read_b128 %7, %9 offset:6144\n\t"
               "s_waitcnt lgkmcnt(0)"
               : "=&v"(x[0]), "=&v"(x[1]), "=&v"(x[2]), "=&v"(x[3]), "=&v"(w[0]), "=&v"(w[1]), "=&v"(w[2]), "=&v"(w[3])
               : "v"(aA), "v"(aB) : "memory");
}
DI void lds_issue_frags_sw(bf16x8 (&x)[4], bf16x8 (&w)[4], unsigned aA, unsigned aB) {
  asm volatile("ds_read_b128 %0, %8\n\tds_read_b128 %1, %8 offset:2048\n\tds_read_b128 %2, %8 offset:4096\n\tds_read_b128 %3, %8 offset:6144\n\t"
               "ds_read_b128 %4, %9\n\tds_read_b128 %5, %9 offset:2048\n\tds_read_b128 %6, %9 offset:4096\n\tds_read_b128 %7, %9 offset:6144"
               : "=&v"(x[0]), "=&v"(x[1]), "=&v"(x[2]), "=&v"(x[3]), "=&v"(w[0]), "=&v"(w[1]), "=&v"(w[2]), "=&v"(w[3])
               : "v"(aA), "v"(aB) : "memory");
}
DI void gemm_mainloop_dma_sw44(const bf16_t* __restrict__ Ag, int lda, const bf16_t* __restrict__ Bg, int ldb, int K,
                               f32x4 (&acc)[4][4], char* smem) {
  constexpr int MT = 4, NT = 4, RA = 128, ROWS = 256, NI = 8, BUF = ROWS * 128;
  const int tid = get_tid(), lane = tid & 63, wave = __builtin_amdgcn_readfirstlane(tid >> 6), wm = wave >> 1, wn = wave & 1, c = lane & 15, g = lane >> 4;
  const bf16_t* src[NI];
#pragma unroll
  for (int i = 0; i < NI; ++i) {
    const int q = tid + 256 * i;
    const int row = q >> 3, x = (q & 7) ^ ((row >> 1) & 7);
    int rb = row - RA;
    { const int t = (rb >> 4) & 3, c4 = rb & 15; rb = (rb & ~63) + 32 * (t >> 1) + 8 * (c4 >> 2) + 4 * (t & 1) + (c4 & 3); }
    src[i] = (row < RA ? Ag + (size_t)row * lda : Bg + (size_t)rb * ldb) + x * 8;
  }
#define DMA_ISSUE(KT, BUFI) { _Pragma("unroll") for (int i = 0; i < NI; ++i) \
    __builtin_amdgcn_global_load_lds((const unsigned*)(src[i] + ((KT) << 6)), (unsigned*)(smem + (BUFI) * BUF + (tid + 256 * i) * 16), 16, 0, 0); }
  const int nk = K >> 6;
  const unsigned f = (unsigned)((c >> 1) & 7);
  const unsigned off0 = ((unsigned)g ^ f) * 16u, off1 = off0 ^ 64u;
  const unsigned rowA = (unsigned)(size_t)smem + (unsigned)((16 * MT * wm + c) * 128);
  const unsigned rowB = (unsigned)(size_t)smem + (unsigned)((RA + 16 * NT * wn + c) * 128);
  __syncthreads();
  DMA_ISSUE(0, 0);
  asm volatile("s_waitcnt vmcnt(0)" ::: "memory");
  __syncthreads();
  for (int kt = 0; kt < nk; ++kt) {
    const int cur = kt & 1;
    if (kt + 1 < nk) DMA_ISSUE(kt + 1, cur ^ 1);
    const unsigned bA = rowA + cur * BUF, bB = rowB + cur * BUF;
    bf16x8 xf[MT], wf[NT], xg[MT], wg[NT];
    lds_read_frags_sw(xf, wf, bA + off0, bB + off0);
    lds_issue_frags_sw(xg, wg, bA + off1, bB + off1);
#pragma unroll
    for (int mt = 0; mt < MT; ++mt)
#pragma unroll
      for (int nt = 0; nt < NT; ++nt) acc[mt][nt] = mfma16(wf[nt], xf[mt], acc[mt][nt]);
    lds_wait_frags(xg, wg, acc[MT - 1][0], acc[MT - 1][1], acc[MT - 1][NT - 2], acc[MT - 1][NT - 1]);
#pragma unroll
    for (int mt = 0; mt < MT; ++mt)
#pragma unroll
      for (int nt = 0; nt < NT; ++nt) acc[mt][nt] = mfma16(wg[nt], xg[mt], acc[mt][nt]);
    asm volatile("s_waitcnt vmcnt(0)" : "+v"(acc[0][0]), "+v"(acc[0][NT - 1]), "+v"(acc[MT - 1][0]), "+v"(acc[MT - 1][NT - 1]) :: "memory");
    __syncthreads();
  }
#undef DMA_ISSUE
}

DI void lds_issue_frags_sw(bf16x8 (&x)[5], bf16x8 (&w)[4], unsigned aA, unsigned aB) {
  asm volatile("ds_read_b128 %0, %9\n\tds_read_b128 %1, %9 offset:2048\n\tds_read_b128 %2, %9 offset:4096\n\tds_read_b128 %3, %9 offset:6144\n\tds_read_b128 %4, %9 offset:8192\n\t"
               "ds_read_b128 %5, %10\n\tds_read_b128 %6, %10 offset:2048\n\tds_read_b128 %7, %10 offset:4096\n\tds_read_b128 %8, %10 offset:6144"
               : "=&v"(x[0]), "=&v"(x[1]), "=&v"(x[2]), "=&v"(x[3]), "=&v"(x[4]), "=&v"(w[0]), "=&v"(w[1]), "=&v"(w[2]), "=&v"(w[3])
               : "v"(aA), "v"(aB) : "memory");
}
DI void lds_wait_frags_sw(bf16x8 (&x)[5], bf16x8 (&w)[4], f32x4& a0, f32x4& a1, f32x4& a2, f32x4& a3) {
  asm volatile("s_waitcnt lgkmcnt(0)"
               : "+v"(x[0]), "+v"(x[1]), "+v"(x[2]), "+v"(x[3]), "+v"(x[4]), "+v"(w[0]), "+v"(w[1]), "+v"(w[2]), "+v"(w[3]),
                 "+v"(a0), "+v"(a1), "+v"(a2), "+v"(a3) :: "memory");
}
DI void gemm_mainloop_dma_sw54p(const bf16_t* __restrict__ Ag, int lda, const bf16_t* __restrict__ Bg, int ldb, int K,
                                f32x4 (&acc)[5][4], char* smem) {
  constexpr int MT = 5, NT = 4, RA = 160, ROWS = 288, NI = 9, BUF = ROWS * 128;
  const int tid = get_tid(), lane = tid & 63, wave = __builtin_amdgcn_readfirstlane(tid >> 6), wm = wave >> 1, wn = wave & 1, c = lane & 15, g = lane >> 4;
  const bf16_t* src[NI];
#pragma unroll
  for (int i = 0; i < NI; ++i) {
    const int q = tid + 256 * i;
    const int row = q >> 3, x = (q & 7) ^ ((row >> 1) & 7);
    int rb = row - RA;
    { const int t = (rb >> 4) & 3, c4 = rb & 15; rb = (rb & ~63) + 32 * (t >> 1) + 8 * (c4 >> 2) + 4 * (t & 1) + (c4 & 3); }
    src[i] = (row < RA ? Ag + (size_t)row * lda : Bg + (size_t)rb * ldb) + x * 8;
  }
#define DMA_ISSUE(KT, BUFI) { _Pragma("unroll") for (int i = 0; i < NI; ++i) \
    __builtin_amdgcn_global_load_lds((const unsigned*)(src[i] + ((KT) << 6)), (unsigned*)(smem + (BUFI) * BUF + (tid + 256 * i) * 16), 16, 0, 0); }
  const int nk = K >> 6;
  const unsigned f = (unsigned)((c >> 1) & 7);
  const unsigned off0 = ((unsigned)g ^ f) * 16u, off1 = off0 ^ 64u;
  const unsigned rowA = (unsigned)(size_t)smem + (unsigned)((16 * MT * wm + c) * 128);
  const unsigned rowB = (unsigned)(size_t)smem + (unsigned)((RA + 16 * NT * wn + c) * 128);
  __syncthreads();
  DMA_ISSUE(0, 0);
  asm volatile("s_waitcnt vmcnt(0)" ::: "memory");
  __syncthreads();
  for (int kt = 0; kt < nk; ++kt) {
    const int cur = kt & 1;
    if (kt + 1 < nk) DMA_ISSUE(kt + 1, cur ^ 1);
    const unsigned bA = rowA + cur * BUF, bB = rowB + cur * BUF;
    bf16x8 xf[MT], wf[NT], xg[MT], wg[NT];
    lds_read_frags_sw(xf, wf, bA + off0, bB + off0);
    lds_issue_frags_sw(xg, wg, bA + off1, bB + off1);
#pragma unroll
    for (int mt = 0; mt < MT; ++mt)
#pragma unroll
      for (int nt = 0; nt < NT; ++nt) acc[mt][nt] = mfma16(wf[nt], xf[mt], acc[mt][nt]);
    lds_wait_frags_sw(xg, wg, acc[MT - 1][0], acc[MT - 1][1], acc[MT - 1][NT - 2], acc[MT - 1][NT - 1]);
#pragma unroll
    for (int mt = 0; mt < MT; ++mt)
#pragma unroll
      for (int nt = 0; nt < NT; ++nt) acc[mt][nt] = mfma16(wg[nt], xg[mt], acc[mt][nt]);
    asm volatile("s_waitcnt vmcnt(0)" : "+v"(acc[0][0]), "+v"(acc[0][NT - 1]), "+v"(acc[MT - 1][0]), "+v"(acc[MT - 1][NT - 1]) :: "memory");
    __syncthreads();
  }
#undef DMA_ISSUE
}

__device__ __forceinline__ void phase_inproj(const Params& p, int layer, char* smem) {
  const int tid = get_tid(), lane = tid & 63, wave = __builtin_amdgcn_readfirstlane(tid >> 6), wm = wave >> 1, wn = wave & 1, c = lane & 15, g = lane >> 4;
  const bf16_t* hm = (const bf16_t*)(p.ws + W_HMOD);
  const bf16_t* wt = (const bf16_t*)(p.ws + W_WTIN) + (size_t)layer * NPAD * 1024;
  bf16_t* parts = (bf16_t*)(p.ws + W_PARTS);
  const float2* rope = (const float2*)(p.ws + W_ROPE);
  const int ntiles = 64 * 67;
  for (int t = blockIdx.x; t < ntiles; t += gridDim.x) {
    const int m0 = (t % 64) * 160, n0 = (t / 64) * 128;
    f32x4 acc[5][4];
    zero_acc<5, 4>(acc);
    gemm_mainloop_dma_sw54p(hm + (size_t)m0 * 1024, 1024, wt + (size_t)n0 * 1024, 1024, 1024, acc, smem);
    const int nb = n0 + 64 * wn;
    const int mb = m0 + 80 * wm;
    if (nb >= 8448) {
      if (nb == 8448 && g < 2) {
        float* dt = (float*)(p.ws + W_DT);
#pragma unroll
        for (int mt = 0; mt < 5; ++mt) {
          const int tok = mb + 16 * mt + c;
          *(f32x4*)(dt + (size_t)tok * 16 + 8 * g) = acc[mt][0];
          *(f32x4*)(dt + (size_t)tok * 16 + 8 * g + 4) = acc[mt][1];
        }
      }
      continue;
    }
    const bool is_qa = nb < 512, is_ka = nb >= 512 && nb < 1024;
    const bool is_va = nb >= 1024 && nb < 1536, is_vc = nb >= 4352 && nb < 4864;
    const bool is_kc = nb >= 3840 && nb < 4352, is_qc = nb >= 3328 && nb < 3840;
    if (is_qa || is_ka) {
      const int fi = 8 * (g & 1);
      const float sgn = (g < 2) ? -1.f : 1.f;
#pragma unroll
      for (int mt = 0; mt < 5; ++mt) {
        if (mb + 16 * mt >= NCTX) {
          const int tl = (mb + 16 * mt + c - NCTX) & 1023;
          const int prow = tl >> 6, pcol = tl & 63;
#pragma unroll
          for (int nt = 0; nt < 4; ++nt) {
            const int pos = (nt >> 1) ? pcol : prow;
#pragma unroll
            for (int r = 0; r < 4; ++r) {
              const float2 cs = rope[pos * 16 + fi + 4 * (nt & 1) + r];
              const float own = acc[mt][nt][r];
              const float oth = __shfl_xor(own, 32);
              acc[mt][nt][r] = own * cs.x + sgn * oth * cs.y;
            }
          }
        }
      }
    }
    if (is_ka || is_va || is_kc || is_vc) {
      size_t obase; int cseg;
      if (is_ka) { obase = O_DK; cseg = nb - 512; }
      else if (is_va) { obase = O_DV; cseg = nb - 1024; }
      else if (is_kc) { obase = O_NK; cseg = nb - 3840; }
      else { obase = O_NV; cseg = nb - 4352; }
#pragma unroll
      for (int mt = 0; mt < 5; ++mt) {
        if (mb + 16 * mt < NCTX) {
          const int tok = mb + 16 * mt + c;
          const int b = tok >> 8, tt = tok & 255;
          float* o = p.out + obase + ((size_t)((b * 2 + layer) * 256 + tt)) * 512 + cseg + 8 * g;
#pragma unroll
          for (int q = 0; q < 2; ++q) { *(f32x4*)(o + 32 * q) = acc[mt][2 * q]; *(f32x4*)(o + 32 * q + 4) = acc[mt][2 * q + 1]; }
        }
      }
    }
    if (is_va || is_vc) {
      bf16_t* vt = (bf16_t*)(p.ws + (is_va ? W_VAT : W_VCT));
      const int cseg = is_va ? nb - 1024 : nb - 4352;
      constexpr int TS = 88;
      bf16_t* T = (bf16_t*)smem + wave * 64 * TS;
#pragma unroll
      for (int mt = 0; mt < 5; ++mt)
#pragma unroll
        for (int nt = 0; nt < 4; ++nt)
#pragma unroll
          for (int r = 0; r < 4; ++r) T[(32 * (nt >> 1) + 8 * g + 4 * (nt & 1) + r) * TS + 16 * mt + c] = f2bf(acc[mt][nt][r]);
#pragma unroll
      for (int j = 0; j < 10; ++j) {
        const int id = lane + 64 * j, rowc = id / 10, chk = id - rowc * 10;
        const u32x4 v = *(const u32x4*)(T + rowc * TS + chk * 8);
        *(u32x4*)(vt + (size_t)(cseg + rowc) * MTOK + mb + chk * 8) = v;
      }
    } else {
      const int pcol = nb < 1024 ? nb : (nb < 4352 ? nb - 512 : nb - 1024);
      const float sc = (is_qa || is_qc) ? 0.125f : 1.f;
#pragma unroll
      for (int mt = 0; mt < 5; ++mt) {
        const int tok = mb + 16 * mt + c;
        bf16_t* o = parts + (size_t)tok * LDP + pcol + 8 * g;
#pragma unroll
        for (int q = 0; q < 2; ++q) {
          u32x4 w;
          w.x = pack2(acc[mt][2 * q][0] * sc, acc[mt][2 * q][1] * sc); w.y = pack2(acc[mt][2 * q][2] * sc, acc[mt][2 * q][3] * sc);
          w.z = pack2(acc[mt][2 * q + 1][0] * sc, acc[mt][2 * q + 1][1] * sc); w.w = pack2(acc[mt][2 * q + 1][2] * sc, acc[mt][2 * q + 1][3] * sc);
          *(u32x4*)(o + 32 * q) = w;
        }
      }
    }
  }
}

struct AttnSeg { const bf16_t* k; int ldk; const bf16_t* v; int ldv; int ntiles; };

template <int NMAP, int DV, bool WIN>
DI void attn_core(const bf16_t* __restrict__ qrow, const AttnSeg s0, const AttnSeg s1, int qc, int dr0, const float* rpb_s,
                  bf16_t* Ks, bf16_t* Vts, f32x4 (&o)[NMAP][DV / 16], float (&lsum)[NMAP]) {
  const int tid = get_tid(), lane = tid & 63, wave = __builtin_amdgcn_readfirstlane(tid >> 6), c = lane & 15, g = lane >> 4;
  constexpr int NKC = NMAP * 2;
  constexpr int NVC = DV / 32;
  bf16x8 qf[NMAP][2];
#pragma unroll
  for (int m = 0; m < NMAP; ++m)
#pragma unroll
    for (int ks = 0; ks < 2; ++ks) qf[m][ks] = *(const bf16x8*)(qrow + m * 64 + 32 * ks + 8 * g);
  float mrun[NMAP];
#pragma unroll
  for (int m = 0; m < NMAP; ++m) {
    mrun[m] = -1e30f; lsum[m] = 0.f;
#pragma unroll
    for (int e = 0; e < DV / 16; ++e) o[m][e] = (f32x4){0.f, 0.f, 0.f, 0.f};
  }
  u32x4 rk[NKC], rv[NVC];
  const int ntot = s0.ntiles + s1.ntiles;
  auto gl = [&](int kt) {
    const bool first = kt < s0.ntiles;
    const int loc = first ? kt : kt - s0.ntiles;
    const bf16_t* kp = first ? s0.k : s1.k; const int ldk = first ? s0.ldk : s1.ldk;
    const bf16_t* vp = first ? s0.v : s1.v; const int ldv = first ? s0.ldv : s1.ldv;
    kp += (size_t)loc * 64 * ldk; vp += loc * 64;
#pragma unroll
    for (int i = 0; i < NKC; ++i) {
      int id = tid + 256 * i; int key = id / (NMAP * 8), cc = id % (NMAP * 8);
      rk[i] = *(const u32x4*)(kp + (size_t)key * ldk + cc * 8);
    }
#pragma unroll
    for (int i = 0; i < NVC; ++i) {
      int id = tid + 256 * i; int e = id >> 3, kc = (id & 7) * 8;
      rv[i] = *(const u32x4*)(vp + (size_t)e * ldv + kc);
    }
  };
  gl(0);
  for (int kt = 0; kt < ntot; ++kt) {
    __syncthreads();
#pragma unroll
    for (int i = 0; i < NKC; ++i) {
      int id = tid + 256 * i; int key = id / (NMAP * 8), cc = id % (NMAP * 8);
      *(u32x4*)(Ks + ((cc >> 3) * 64 + key) * LS + (cc & 7) * 8) = rk[i];
    }
#pragma unroll
    for (int i = 0; i < NVC; ++i) {
      int id = tid + 256 * i; int e = id >> 3, kc = (id & 7) * 8;
      *(u32x4*)(Vts + e * LS + kc) = rv[i];
    }
    __syncthreads();
    if (kt + 1 < ntot) gl(kt + 1);
    const bool win = WIN && kt >= s0.ntiles;
    const int nblk = win ? 1 : 2;
    for (int T = 0; T < nblk; ++T) {
      int kb = T * 32;
      if (win) kb = (wave == 0) ? 0 : (wave == 1 ? 8 : (wave == 2 ? 24 : 32));
      bf16x8 pf[NMAP];
      float alpha[NMAP];
#pragma unroll
      for (int m = 0; m < NMAP; ++m) {
        f32x4 sa = (f32x4){0.f, 0.f, 0.f, 0.f}, sb = sa;
        const int krow = kb + 8 * (c >> 2) + (c & 3);
#pragma unroll
        for (int ks = 0; ks < 2; ++ks) {
          bf16x8 a0 = lds_frag(Ks + m * 64 * LS, krow, 32 * ks + 8 * g);
          bf16x8 a1 = lds_frag(Ks + m * 64 * LS, krow + 4, 32 * ks + 8 * g);
          sa = mfma16(a0, qf[m][ks], sa);
          sb = mfma16(a1, qf[m][ks], sb);
        }
        if (win) {
          const int dr = dr0 + (kt - s0.ntiles);
          const int cs = min(max(qc - 8, 0), 48);
#pragma unroll
          for (int r = 0; r < 4; ++r) {
            int kc0 = kb + 8 * g + r, kc1 = kc0 + 4;
            int dc0 = min(max(kc0 - qc, -15), 15) + 15, dc1 = min(max(kc1 - qc, -15), 15) + 15;
            bool v0 = kc0 >= cs && kc0 < cs + 16, v1 = kc1 >= cs && kc1 < cs + 16;
            sa[r] = v0 ? sa[r] + rpb_s[dr * 31 + dc0] : -1e30f;
            sb[r] = v1 ? sb[r] + rpb_s[dr * 31 + dc1] : -1e30f;
          }
        }
        float mx = fmaxf(fmaxf(fmaxf(sa[0], sa[1]), fmaxf(sa[2], sa[3])), fmaxf(fmaxf(sb[0], sb[1]), fmaxf(sb[2], sb[3])));
        mx = fmaxf(mx, __shfl_xor(mx, 16));
        mx = fmaxf(mx, __shfl_xor(mx, 32));
        const float mnew = fmaxf(mrun[m], mx);
        alpha[m] = __expf(mrun[m] - mnew);
        mrun[m] = mnew;
        float ps = 0.f;
#pragma unroll
        for (int r = 0; r < 4; ++r) { sa[r] = __expf(sa[r] - mnew); sb[r] = __expf(sb[r] - mnew); ps += sa[r] + sb[r]; }
        lsum[m] = lsum[m] * alpha[m] + ps;
        union { u32x4 u; bf16x8 v; } cv;
        cv.u.x = pack2(sa[0], sa[1]); cv.u.y = pack2(sa[2], sa[3]); cv.u.z = pack2(sb[0], sb[1]); cv.u.w = pack2(sb[2], sb[3]);
        pf[m] = cv.v;
      }
#pragma unroll
      for (int e = 0; e < DV / 16; ++e) {
        bf16x8 vf = lds_frag(Vts, 16 * e + c, kb + 8 * g);
#pragma unroll
        for (int m = 0; m < NMAP; ++m) {
          f32x4 t = o[m][e] * alpha[m];
          o[m][e] = mfma16(vf, pf[m], t);
        }
      }
    }
  }
#pragma unroll
  for (int m = 0; m < NMAP; ++m) {
    float l = lsum[m];
    l += __shfl_xor(l, 16);
    l += __shfl_xor(l, 32);
    lsum[m] = l;
  }
}

__device__ __forceinline__ void item_diff_attn(const Params& p, int layer, bool lat, int b, int h, int qb, char* smem) {
  bf16_t* Ks = (bf16_t*)smem;
  bf16_t* Vts = Ks + 2 * 64 * LS;
  const int lane = get_tid() & 63, wave = __builtin_amdgcn_readfirstlane(get_tid() >> 6), c = lane & 15, g = lane >> 4;
  const bf16_t* parts = (const bf16_t*)(p.ws + W_PARTS);
  const bf16_t* vat = (const bf16_t*)(p.ws + W_VAT);
  const int row0 = lat ? NCTX + b * 1024 : b * 256;
  const int L = lat ? 1024 : 256;
  const int qrow_i = row0 + qb * 64 + 16 * wave + c;
  AttnSeg s0, s1;
  s0.k = parts + (size_t)row0 * LDP + PC_KA + h * 128; s0.ldk = LDP;
  s0.v = vat + (size_t)(h * 128) * MTOK + row0; s0.ldv = MTOK; s0.ntiles = L / 64;
  if (lat) {
    s1.k = (const bf16_t*)(p.ws + W_CKA) + (size_t)(b * 2 + layer) * 512 * 512 + h * 128; s1.ldk = 512;
    s1.v = (const bf16_t*)(p.ws + W_CVTA) + (size_t)(b * 2 + layer) * 512 * 512 + (size_t)(h * 128) * 512; s1.ldv = 512; s1.ntiles = 8;
  } else { s1 = s0; s1.ntiles = 0; }
  f32x4 o[2][8]; float ls[2];
  attn_core<2, 128, false>(parts + (size_t)qrow_i * LDP + PC_QA + h * 128, s0, s1, 0, 0, nullptr, Ks, Vts, o, ls);
  const float lam = ((const float*)(p.ws + W_LAM))[layer];
  const float li = lam_init_of(layer);
  const float i0 = 1.f / ls[0], i1 = lam / ls[1];
  float ss = 0.f;
#pragma unroll
  for (int e = 0; e < 8; ++e)
#pragma unroll
    for (int r = 0; r < 4; ++r) { float v = o[0][e][r] * i0 - o[1][e][r] * i1; o[0][e][r] = v; ss += v * v; }
  ss += __shfl_xor(ss, 16);
  ss += __shfl_xor(ss, 32);
  const float rstd = rsqrtf(ss * (1.f / 128.f) + EPS) * (1.f - li);
  const float* sg = p.subln_g + layer * 128;
  const bf16_t* ga = parts + (size_t)qrow_i * LDP + PC_GA + h * 128;
  bf16_t* ya = (bf16_t*)(p.ws + W_PARTS) + (size_t)qrow_i * LDP + PC_QA + h * 128;
#pragma unroll
  for (int e = 0; e < 8; ++e) {
    int ec = 16 * e + 4 * g;
    u32x2 gv = *(const u32x2*)(ga + ec);
    f32x4 sgv = *(const f32x4*)(sg + ec);
    float v0 = o[0][e][0] * rstd * sgv[0] * siluf(bflo(gv.x));
    float v1 = o[0][e][1] * rstd * sgv[1] * siluf(bfhi(gv.x));
    float v2 = o[0][e][2] * rstd * sgv[2] * siluf(bflo(gv.y));
    float v3 = o[0][e][3] * rstd * sgv[3] * siluf(bfhi(gv.y));
    u32x2 w; w.x = pack2(v0, v1); w.y = pack2(v2, v3);
    *(u32x2*)(ya + ec) = w;
  }
}

__device__ __forceinline__ void item_c_attn(const Params& p, int layer, bool lat, int b, int h, int qb, char* smem) {
  bf16_t* Ks = (bf16_t*)smem;
  bf16_t* Vts = Ks + 2 * 64 * LS;
  float* rpb_s = (float*)(Vts + 128 * LS);
  const int lane = get_tid() & 63, wave = __builtin_amdgcn_readfirstlane(get_tid() >> 6), c = lane & 15, g = lane >> 4;
  const bf16_t* parts = (const bf16_t*)(p.ws + W_PARTS);
  const bf16_t* vct = (const bf16_t*)(p.ws + W_VCT);
  f32x4 o[1][4]; float ls[1];
  int qrow_i;
  if (!lat) {
    const int row0 = b * 256;
    qrow_i = row0 + qb * 64 + 16 * wave + c;
    AttnSeg s0, s1;
    s0.k = parts + (size_t)row0 * LDP + PC_KC + h * 64; s0.ldk = LDP;
    s0.v = vct + (size_t)(h * 64) * MTOK + row0; s0.ldv = MTOK; s0.ntiles = 4;
    s1 = s0; s1.ntiles = 0;
    attn_core<1, 64, false>(parts + (size_t)qrow_i * LDP + PC_QC + h * 64, s0, s1, 0, 0, nullptr, Ks, Vts, o, ls);
  } else {
    const int row0 = NCTX + b * 1024;
    const int r = qb;
    qrow_i = row0 + r * 64 + 16 * wave + c;
    const int r0 = min(max(r - 4, 0), 8);
    __syncthreads();
    for (int i = get_tid(); i < 465; i += 256) rpb_s[i] = p.na_rpb[((size_t)layer * 8 + h) * 465 + i];
    __syncthreads();
    AttnSeg s0, s1;
    s0.k = (const bf16_t*)(p.ws + W_CKC) + (size_t)(b * 2 + layer) * 512 * 512 + h * 64; s0.ldk = 512;
    s0.v = (const bf16_t*)(p.ws + W_CVTC) + (size_t)(b * 2 + layer) * 512 * 512 + (size_t)(h * 64) * 512; s0.ldv = 512; s0.ntiles = 8;
    s1.k = parts + (size_t)(row0 + r0 * 64) * LDP + PC_KC + h * 64; s1.ldk = LDP;
    s1.v = vct + (size_t)(h * 64) * MTOK + row0 + r0 * 64; s1.ldv = MTOK; s1.ntiles = 8;
    attn_core<1, 64, true>(parts + (size_t)qrow_i * LDP + PC_QC + h * 64, s0, s1, 16 * wave + c, r0 - r + 7, rpb_s, Ks, Vts, o, ls);
  }
  const float inv = 1.f / ls[0];
  const bf16_t* gc = parts + (size_t)qrow_i * LDP + PC_GC + h * 64;
  bf16_t* yc = (bf16_t*)(p.ws + W_PARTS) + (size_t)qrow_i * LDP + PC_QC + h * 64;
#pragma unroll
  for (int e = 0; e < 4; ++e) {
    int ec = 16 * e + 4 * g;
    u32x2 gv = *(const u32x2*)(gc + ec);
    float v0 = o[0][e][0] * inv * siluf(bflo(gv.x));
    float v1 = o[0][e][1] * inv * siluf(bfhi(gv.x));
    float v2 = o[0][e][2] * inv * siluf(bflo(gv.y));
    float v3 = o[0][e][3] * inv * siluf(bfhi(gv.y));
    u32x2 w; w.x = pack2(v0, v1); w.y = pack2(v2, v3);
    *(u32x2*)(yc + ec) = w;
  }
}

DI int ssd_slot(bool lat, int b, int h, int d, int cd) { return lat ? 2048 + ((b * 8 + h) * 2 + d) * 16 + cd : ((b * 8 + h) * 2 + d) * 4 + cd; }

__device__ __forceinline__ void item_ssd1(const Params& p, int layer, bool lat, int b, int gq, int ch, char* smem) {
  bf16_t* Cs = (bf16_t*)smem;
  bf16_t* Bs = Cs + 64 * LS;
  bf16_t* BsT = Bs + 64 * LS;
  bf16_t* XsT = BsT + 64 * LS;
  float* acum = (float*)(XsT + 4 * 64 * LS);
  float* dts = acum + 512;
  const int tid = get_tid(), lane = tid & 63, wave = __builtin_amdgcn_readfirstlane(tid >> 6), c = lane & 15, g = lane >> 4;
  const int row0 = lat ? NCTX + b * 1024 : b * 256;
  const int L = lat ? 1024 : 256;
  const int nch = L / 64;
  const int tbase = row0 + 64 * ch;
  const bf16_t* parts = (const bf16_t*)(p.ws + W_PARTS);
  const float* dtg = (const float*)(p.ws + W_DT);
  float* eag = (float*)(p.ws + W_EA);
  bf16_t* ccg = (bf16_t*)(p.ws + W_CC);
  bf16_t* scg = (bf16_t*)(p.ws + W_HMOD);
  __syncthreads();
#pragma unroll
  for (int q = 0; q < 2; ++q) {
    const int hd = wave + 4 * q, d = hd >> 2, h = gq * 4 + (hd & 3);
    float raw = dtg[(size_t)(tbase + lane) * 16 + d * 8 + h] + p.dt_bias[(layer * 2 + d) * 8 + h];
    float dt = raw > 20.f ? raw : log1pf(expf(raw));
    float la = dt * (-expf(p.a_log[(layer * 2 + d) * 8 + h]));
    if (d == 0) {
#pragma unroll
      for (int off = 1; off < 64; off <<= 1) { float t = __shfl_up(la, off); if (lane >= off) la += t; }
    } else {
#pragma unroll
      for (int off = 1; off < 64; off <<= 1) { float t = __shfl_down(la, off); if (lane + off < 64) la += t; }
    }
    acum[hd * 64 + lane] = la; dts[hd * 64 + lane] = dt;
    eag[(size_t)(tbase + lane) * 16 + d * 8 + h] = __expf(la);
  }
#pragma unroll
  for (int grp = 0; grp < 3; ++grp) {
    u32x4 rv[4][5];
#pragma unroll
    for (int u = 0; u < 4; ++u) {
      const int it = grp * 4 + u;
      const int vi = tid + 256 * it;
      int i, chn;
      if (it < 8) { i = vi >> 5; chn = gq * 256 + (vi & 31) * 8; }
      else if (it < 10) { int rem = vi - 2048; i = rem >> 3; chn = 512 + gq * 64 + (rem & 7) * 8; }
      else { int rem = vi - 2560; i = rem >> 3; chn = 640 + gq * 64 + (rem & 7) * 8; }
      const int tok = 64 * ch + i;
#pragma unroll
      for (int k = 0; k < 5; ++k) {
        const int tt = tok + k - 2;
        rv[u][k] = (u32x4){0u, 0u, 0u, 0u};
        if (tt >= 0 && tt < L) rv[u][k] = *(const u32x4*)(parts + (size_t)(row0 + tt) * LDP + PC_XBC + chn);
      }
    }
#pragma unroll
    for (int u = 0; u < 4; ++u) {
      const int it = grp * 4 + u;
      const int vi = tid + 256 * it;
      int i, cc, chn;
      if (it < 8) { i = vi >> 5; cc = (vi & 31) * 8; chn = gq * 256 + cc; }
      else if (it < 10) { int rem = vi - 2048; i = rem >> 3; cc = (rem & 7) * 8; chn = 512 + gq * 64 + cc; }
      else { int rem = vi - 2560; i = rem >> 3; cc = (rem & 7) * 8; chn = 640 + gq * 64 + cc; }
      float a8[8];
      {
        const float* cb = p.conv_b + layer * 768 + chn;
        f32x4 b0 = *(const f32x4*)cb, b1 = *(const f32x4*)(cb + 4);
        a8[0] = b0[0]; a8[1] = b0[1]; a8[2] = b0[2]; a8[3] = b0[3]; a8[4] = b1[0]; a8[5] = b1[1]; a8[6] = b1[2]; a8[7] = b1[3];
      }
#pragma unroll
      for (int k = 0; k < 5; ++k) {
        float f[8]; unpack8(rv[u][k], f);
        const float* cw = p.conv_w + (size_t)(layer * 5 + k) * 768 + chn;
        f32x4 w0 = *(const f32x4*)cw, w1 = *(const f32x4*)(cw + 4);
        a8[0] += w0[0] * f[0]; a8[1] += w0[1] * f[1]; a8[2] += w0[2] * f[2]; a8[3] += w0[3] * f[3];
        a8[4] += w1[0] * f[4]; a8[5] += w1[1] * f[5]; a8[6] += w1[2] * f[6]; a8[7] += w1[3] * f[7];
      }
#pragma unroll
      for (int j = 0; j < 8; ++j) a8[j] = siluf(a8[j]);
      if (it < 8) {
        bf16_t* xd = XsT + (cc >> 6) * 64 * LS + (cc & 63) * LS + i;
#pragma unroll
        for (int j = 0; j < 8; ++j) xd[j * LS] = f2bf(a8[j]);
      } else {
        u32x4 w; w.x = pack2(a8[0], a8[1]); w.y = pack2(a8[2], a8[3]); w.z = pack2(a8[4], a8[5]); w.w = pack2(a8[6], a8[7]);
        if (it < 10) {
          *(u32x4*)(Bs + i * LS + cc) = w;
#pragma unroll
          for (int j = 0; j < 8; ++j) BsT[(cc + j) * LS + i] = f2bf(a8[j]);
        } else {
          *(u32x4*)(Cs + i * LS + cc) = w;
          *(u32x4*)(ccg + (size_t)(tbase + i) * 128 + gq * 64 + cc) = w;
        }
      }
    }
  }
  __syncthreads();
  const int il = 16 * wave + c;
  bf16x8 cf[2];
  cf[0] = lds_frag(Cs, il, 8 * g); cf[1] = lds_frag(Cs, il, 32 + 8 * g);
  f32x4 ga[2], gb[2];
#pragma unroll
  for (int T = 0; T < 2; ++T) {
    ga[T] = (f32x4){0.f, 0.f, 0.f, 0.f}; gb[T] = ga[T];
    const int jrow = 32 * T + 8 * (c >> 2) + (c & 3);
#pragma unroll
    for (int ks = 0; ks < 2; ++ks) {
      ga[T] = mfma16(lds_frag(Bs, jrow, 32 * ks + 8 * g), cf[ks], ga[T]);
      gb[T] = mfma16(lds_frag(Bs, jrow + 4, 32 * ks + 8 * g), cf[ks], gb[T]);
    }
  }
  float btf[2][8];
#pragma unroll
  for (int ks = 0; ks < 2; ++ks) {
    u32x4 v = *(const u32x4*)(BsT + (16 * wave + c) * LS + 32 * ks + 8 * g);
    unpack8(v, btf[ks]);
  }
#pragma unroll 1
  for (int hd = 0; hd < 8; ++hd) {
    const int d = hd >> 2, hp = hd & 3, h = gq * 4 + hp;
    const float* ac = acum + hd * 64;
    const float* dtv = dts + hd * 64;
    const bf16_t* Xh = XsT + hp * 64 * LS;
    const float ai = ac[il];
    f32x4 yacc[4];
#pragma unroll
    for (int pt = 0; pt < 4; ++pt) yacc[pt] = (f32x4){0.f, 0.f, 0.f, 0.f};
#pragma unroll
    for (int T = 0; T < 2; ++T) {
      const bool skipT = (d == 0) ? (T == 1 && wave < 2) : (T == 0 && wave >= 2);
      if (!skipT) {
        float pa[4], pb[4];
#pragma unroll
        for (int r = 0; r < 4; ++r) {
          const int j0 = 32 * T + 8 * g + r, j1 = j0 + 4;
          const bool ok0 = (d == 0) ? (j0 <= il) : (j0 >= il);
          const bool ok1 = (d == 0) ? (j1 <= il) : (j1 >= il);
          const float f0 = ok0 ? __expf(fminf(ai - ac[j0], 0.f)) * dtv[j0] : 0.f;
          const float f1 = ok1 ? __expf(fminf(ai - ac[j1], 0.f)) * dtv[j1] : 0.f;
          pa[r] = ga[T][r] * f0; pb[r] = gb[T][r] * f1;
        }
        union { u32x4 u; bf16x8 v; } cv;
        cv.u.x = pack2(pa[0], pa[1]); cv.u.y = pack2(pa[2], pa[3]); cv.u.z = pack2(pb[0], pb[1]); cv.u.w = pack2(pb[2], pb[3]);
#pragma unroll
        for (int pt = 0; pt < 4; ++pt) yacc[pt] = mfma16(lds_frag(Xh, 16 * pt + c, 32 * T + 8 * g), cv.v, yacc[pt]);
      }
    }
    if (d == 0) {
      const float dsk = p.d_skip[(layer * 2 + 0) * 8 + h] + p.d_skip[(layer * 2 + 1) * 8 + h];
#pragma unroll
      for (int pt = 0; pt < 4; ++pt)
#pragma unroll
        for (int r = 0; r < 4; ++r) yacc[pt][r] += dsk * bf2f(Xh[(16 * pt + 4 * g + r) * LS + il]);
    }
    {
      bf16_t* yo = (bf16_t*)(p.ws + (d == 0 ? W_YBF : W_YBB)) + (size_t)(tbase + il) * 512 + h * 64 + 4 * g;
#pragma unroll
      for (int pt = 0; pt < 4; ++pt) {
        u32x2 w; w.x = pack2(yacc[pt][0], yacc[pt][1]); w.y = pack2(yacc[pt][2], yacc[pt][3]);
        *(u32x2*)(yo + 16 * pt) = w;
      }
    }
    {
      const float aend = (d == 0) ? ac[63] : ac[0];
      bf16x8 aw[2];
#pragma unroll
      for (int ks = 0; ks < 2; ++ks) {
        float s8[8];
#pragma unroll
        for (int e = 0; e < 8; ++e) { const int j = 32 * ks + 8 * g + e; s8[e] = btf[ks][e] * dtv[j] * __expf(aend - ac[j]); }
        union { u32x4 u; bf16x8 v; } cv;
        cv.u.x = pack2(s8[0], s8[1]); cv.u.y = pack2(s8[2], s8[3]); cv.u.z = pack2(s8[4], s8[5]); cv.u.w = pack2(s8[6], s8[7]);
        aw[ks] = cv.v;
      }
      const int cd = (d == 0) ? ch : nch - 1 - ch;
      bf16_t* so = scg + (size_t)ssd_slot(lat, b, h, d, cd) * 4096 + 16 * wave + 4 * g;
#pragma unroll
      for (int pt = 0; pt < 4; ++pt) {
        f32x4 t = (f32x4){0.f, 0.f, 0.f, 0.f};
#pragma unroll
        for (int ks = 0; ks < 2; ++ks) t = mfma16(aw[ks], lds_frag(Xh, 16 * pt + c, 32 * ks + 8 * g), t);
        u32x2 w; w.x = pack2(t[0], t[1]); w.y = pack2(t[2], t[3]);
        *(u32x2*)(so + (16 * pt + c) * 64) = w;
      }
    }
  }
}

template <int NCH>
DI void ssd_scan_chain(const Params& p, int layer, bool lat, int b, int h, int d, int half) {
  const int tid = get_tid();
  const int e = half * 2048 + tid * 8;
  const int row0 = lat ? NCTX + b * 1024 : b * 256;
  bf16_t* sc = (bf16_t*)(p.ws + W_HMOD) + (size_t)ssd_slot(lat, b, h, d, 0) * 4096 + e;
  const float* eag = (const float*)(p.ws + W_EA);
  float hr[8];
  if (lat) {
    const float* h0 = p.state_ssd + ((size_t)((b * 2 + layer) * 2 + d) * 8 + h) * 4096 + e;
    f32x4 a = *(const f32x4*)h0, bq = *(const f32x4*)(h0 + 4);
    hr[0] = a[0]; hr[1] = a[1]; hr[2] = a[2]; hr[3] = a[3]; hr[4] = bq[0]; hr[5] = bq[1]; hr[6] = bq[2]; hr[7] = bq[3];
  } else {
#pragma unroll
    for (int j = 0; j < 8; ++j) hr[j] = 0.f;
  }
  u32x4 tmp[NCH];
  float dec[NCH];
#pragma unroll
  for (int cd = 0; cd < NCH; ++cd) {
    tmp[cd] = *(const u32x4*)(sc + (size_t)cd * 4096);
    const int cf = d ? NCH - 1 - cd : cd;
    dec[cd] = eag[(size_t)(row0 + 64 * cf + (d ? 0 : 63)) * 16 + d * 8 + h];
  }
#pragma unroll
  for (int cd = 0; cd < NCH; ++cd) {
    u32x4 w; w.x = pack2(hr[0], hr[1]); w.y = pack2(hr[2], hr[3]); w.z = pack2(hr[4], hr[5]); w.w = pack2(hr[6], hr[7]);
    *(u32x4*)(sc + (size_t)cd * 4096) = w;
    float f[8]; unpack8(tmp[cd], f);
#pragma unroll
    for (int j = 0; j < 8; ++j) hr[j] = dec[cd] * hr[j] + f[j];
  }
  if (!lat) {
    float* ho = p.out + O_SS + ((size_t)((b * 2 + layer) * 2 + d) * 8 + h) * 4096 + e;
    *(f32x4*)ho = (f32x4){hr[0], hr[1], hr[2], hr[3]};
    *(f32x4*)(ho + 4) = (f32x4){hr[4], hr[5], hr[6], hr[7]};
  }
}

__device__ __forceinline__ void phase_ssd_scan(const Params& p, int layer) {
  for (int i = blockIdx.x * 256 + get_tid(); i < MTOK; i += gridDim.x * 256) ((float*)(p.ws + W_RSTD))[i] = 0.f;
  for (int it = blockIdx.x; it < 1088; it += gridDim.x) {
    const int chain = it >> 1, half = it & 1;
    if (chain < 512) ssd_scan_chain<4>(p, layer, false, chain >> 4, (chain >> 1) & 7, chain & 1, half);
    else { const int cl = chain - 512; ssd_scan_chain<16>(p, layer, true, cl >> 4, (cl >> 1) & 7, cl & 1, half); }
  }
}

__device__ __forceinline__ void phase_ssd_final(const Params& p, int layer, char* smem) {
  bf16_t* Cs2 = (bf16_t*)smem;
  bf16_t* Hs = Cs2 + 2 * 64 * LS;
  float* eas = (float*)(Hs + 2 * 64 * LS);
  const int tid = get_tid(), lane = tid & 63, wave = __builtin_amdgcn_readfirstlane(tid >> 6), c = lane & 15, g = lane >> 4;
  const bf16_t* parts = (const bf16_t*)(p.ws + W_PARTS);
  const bf16_t* scg = (const bf16_t*)(p.ws + W_HMOD);
  const bf16_t* ccg = (const bf16_t*)(p.ws + W_CC);
  const float* eag = (const float*)(p.ws + W_EA);
  bf16_t* yf = (bf16_t*)(p.ws + W_YBF);
  const bf16_t* ybk = (const bf16_t*)(p.ws + W_YBB);
  const float* ng = p.ssd_norm_g + layer * 512;
  for (int it2 = blockIdx.x; it2 < 320; it2 += gridDim.x) {
    const int it = it2 >> 1, hh = it2 & 1;
    const bool lat = it >= 128;
    const int b = lat ? (it - 128) >> 4 : it >> 2;
    const int ch = lat ? (it - 128) & 15 : it & 3;
    const int nch = lat ? 16 : 4;
    const int tbase = (lat ? NCTX + b * 1024 : b * 256) + 64 * ch;
    __syncthreads();
#pragma unroll
    for (int i4 = 0; i4 < 4; ++i4) {
      int vi = tid + 256 * i4; int i = vi >> 4, cc = (vi & 15) * 8;
      u32x4 v = *(const u32x4*)(ccg + (size_t)(tbase + i) * 128 + cc);
      *(u32x4*)(Cs2 + (cc >> 6) * 64 * LS + i * LS + (cc & 63)) = v;
    }
    *(f32x4*)(eas + tid * 4) = *(const f32x4*)(eag + (size_t)tbase * 16 + tid * 4);
    const int il = 16 * wave + c;
    const size_t row = (size_t)(tbase + il);
    u32x4 hreg[2];
    {
      const bf16_t* s = scg + (size_t)ssd_slot(lat, b, 4 * hh, 0, ch) * 4096;
      hreg[0] = *(const u32x4*)(s + tid * 8); hreg[1] = *(const u32x4*)(s + 2048 + tid * 8);
    }
    float ss = 0.f;
#pragma unroll 1
    for (int h = 4 * hh; h < 4 * hh + 4; ++h) {
      f32x4 y[4];
#pragma unroll
      for (int pt = 0; pt < 4; ++pt) y[pt] = (f32x4){0.f, 0.f, 0.f, 0.f};
#pragma unroll
      for (int d = 0; d < 2; ++d) {
        bf16_t* Hb = Hs + d * 64 * LS;
        {
          int e0 = tid * 8;
          *(u32x4*)(Hb + (e0 >> 6) * LS + (e0 & 63)) = hreg[0];
          *(u32x4*)(Hb + ((e0 + 2048) >> 6) * LS + (e0 & 63)) = hreg[1];
        }
        __syncthreads();
        {
          const int k1 = 2 * h + d + 1;
          if (k1 < 8 * hh + 8) {
            const int h2 = k1 >> 1, d2 = k1 & 1;
            const bf16_t* s = scg + (size_t)ssd_slot(lat, b, h2, d2, d2 ? nch - 1 - ch : ch) * 4096;
            hreg[0] = *(const u32x4*)(s + tid * 8); hreg[1] = *(const u32x4*)(s + 2048 + tid * 8);
          }
        }
        const bf16_t* Cq = Cs2 + (h >> 2) * 64 * LS;
        const bf16x8 c0 = lds_frag(Cq, il, 8 * g), c1 = lds_frag(Cq, il, 32 + 8 * g);
        const float ea = eas[il * 16 + d * 8 + h];
#pragma unroll
        for (int pt = 0; pt < 4; ++pt) {
          f32x4 t = (f32x4){0.f, 0.f, 0.f, 0.f};
          t = mfma16(lds_frag(Hb, 16 * pt + c, 8 * g), c0, t);
          t = mfma16(lds_frag(Hb, 16 * pt + c, 32 + 8 * g), c1, t);
          y[pt] += t * ea;
        }
      }
#pragma unroll
      for (int pt = 0; pt < 4; ++pt) {
        const int col = h * 64 + 16 * pt + 4 * g;
        u32x2 a = *(const u32x2*)(yf + row * 512 + col);
        u32x2 bq = *(const u32x2*)(ybk + row * 512 + col);
        u32x2 z = *(const u32x2*)(parts + row * LDP + PC_Z + col);
        f32x4 gv = *(const f32x4*)(ng + col);
        float y0 = (y[pt][0] + bflo(a.x) + bflo(bq.x)) * siluf(bflo(z.x));
        float y1 = (y[pt][1] + bfhi(a.x) + bfhi(bq.x)) * siluf(bfhi(z.x));
        float y2 = (y[pt][2] + bflo(a.y) + bflo(bq.y)) * siluf(bflo(z.y));
        float y3 = (y[pt][3] + bfhi(a.y) + bfhi(bq.y)) * siluf(bfhi(z.y));
        ss += y0 * y0 + y1 * y1 + y2 * y2 + y3 * y3;
        u32x2 w; w.x = pack2(y0 * gv[0], y1 * gv[1]); w.y = pack2(y2 * gv[2], y3 * gv[3]);
        *(u32x2*)(yf + row * 512 + col) = w;
      }
    }
    ss += __shfl_xor(ss, 16);
    ss += __shfl_xor(ss, 32);
    if (g == 0) atomicAdd((float*)(p.ws + W_RSTD) + row, ss);
  }
}

__device__ __forceinline__ void phase_mixers(const Params& p, int layer, char* smem) {
  constexpr int N0 = 128, N1 = N0 + 256, N2 = N1 + 64, N3 = N2 + 256, N4 = N3 + 512, N5 = N4 + 1024;
  __shared__ int s_item;
  unsigned* ctr = (unsigned*)(p.ws + W_BAR) + 3584 + 64 * layer;
  for (;;) {
    __syncthreads();
    if (threadIdx.x == 0) s_item = (int)atomicAdd(ctr, 1u);
    __syncthreads();
    const int it = __builtin_amdgcn_readfirstlane(s_item);
    if (it >= N5) break;
    if (it < N0) { int j = it; item_diff_attn(p, layer, true, j >> 6, (j >> 4) & 3, j & 15, smem); }
    else if (it < N1) { int j = it - N0; item_c_attn(p, layer, true, j >> 7, (j >> 4) & 7, j & 15, smem); }
    else if (it < N2) { int j = it - N1; item_ssd1(p, layer, true, j >> 5, (j >> 4) & 1, j & 15, smem); }
    else if (it < N3) { int j = it - N2; item_ssd1(p, layer, false, j >> 3, (j >> 2) & 1, j & 3, smem); }
    else if (it < N4) { int j = it - N3; item_diff_attn(p, layer, false, j >> 4, (j >> 2) & 3, j & 3, smem); }
    else { int j = it - N4; item_c_attn(p, layer, false, j >> 5, (j >> 2) & 7, j & 3, smem); }
  }
}

__device__ __forceinline__ void phase_branch(const Params& p, int layer, char* smem) {
  const int tid = get_tid(), lane = tid & 63, wave = __builtin_amdgcn_readfirstlane(tid >> 6), wm = wave >> 1, wn = wave & 1, c = lane & 15, g = lane >> 4;
  const bf16_t* parts = (const bf16_t*)(p.ws + W_PARTS);
  const int ntiles = 64 * 8;
  for (int t = blockIdx.x; t < ntiles; t += gridDim.x) {
    const int m0 = (t % 64) * 160, n0 = (t / 64) * 128;
    const int mb = m0 + 80 * wm, nb = n0 + 64 * wn;
    f32x4 tot[5][4];
    zero_acc<5, 4>(tot);
#pragma unroll 1
    for (int br = 0; br < 3; ++br) {
      const bf16_t* A = (br == 0) ? parts + PC_QA : (br == 1 ? (const bf16_t*)(p.ws + W_YBF) : parts + PC_QC);
      const int lda = (br == 1) ? 512 : LDP;
      const bf16_t* Bt = (const bf16_t*)(p.ws + W_WTBR) + (size_t)(layer * 3 + br) * 1024 * 512;
      f32x4 acc[5][4];
      zero_acc<5, 4>(acc);
      gemm_mainloop_dma_sw<true, 4>(A + (size_t)m0 * lda, lda, Bt + (size_t)n0 * 512, 512, 512, acc, smem);
      int lane_e = lane; asm volatile("" : "+v"(lane_e));
      const int ce = lane_e & 15, ge = lane_e >> 4;
#pragma unroll
      for (int mt = 0; mt < 5; ++mt) {
        const int tok = mb + 16 * mt + ce;
        const float rs = (br == 1) ? rsqrtf(((const float*)(p.ws + W_RSTD))[tok] * (1.f / 512.f) + EPS) : 1.f;
#pragma unroll
        for (int q = 0; q < 2; ++q) {
          const u32x4 v = *(const u32x4*)(parts + (size_t)tok * LDP + PC_MG + br * 1024 + nb + 32 * q + 8 * ge);
          tot[mt][2 * q][0] += sigmf(bflo(v.x)) * rs * acc[mt][2 * q][0];
          tot[mt][2 * q][1] += sigmf(bfhi(v.x)) * rs * acc[mt][2 * q][1];
          tot[mt][2 * q][2] += sigmf(bflo(v.y)) * rs * acc[mt][2 * q][2];
          tot[mt][2 * q][3] += sigmf(bfhi(v.y)) * rs * acc[mt][2 * q][3];
          tot[mt][2 * q + 1][0] += sigmf(bflo(v.z)) * rs * acc[mt][2 * q + 1][0];
          tot[mt][2 * q + 1][1] += sigmf(bfhi(v.z)) * rs * acc[mt][2 * q + 1][1];
          tot[mt][2 * q + 1][2] += sigmf(bflo(v.w)) * rs * acc[mt][2 * q + 1][2];
          tot[mt][2 * q + 1][3] += sigmf(bfhi(v.w)) * rs * acc[mt][2 * q + 1][3];
        }
      }
    }
#pragma unroll
    for (int mt = 0; mt < 5; ++mt) {
      const int tok = mb + 16 * mt + c;
#pragma unroll
      for (int q = 0; q < 2; ++q) {
        u32x4 w;
        w.x = pack2(tot[mt][2 * q][0], tot[mt][2 * q][1]); w.y = pack2(tot[mt][2 * q][2], tot[mt][2 * q][3]);
        w.z = pack2(tot[mt][2 * q + 1][0], tot[mt][2 * q + 1][1]); w.w = pack2(tot[mt][2 * q + 1][2], tot[mt][2 * q + 1][3]);
        *(u32x4*)((bf16_t*)(p.ws + W_HMOD) + (size_t)tok * 1024 + nb + 32 * q + 8 * g) = w;
      }
    }
  }
}

__device__ __forceinline__ void phase_outproj(const Params& p, int layer, char* smem) {
  const int tid = get_tid(), lane = tid & 63, wave = __builtin_amdgcn_readfirstlane(tid >> 6), wm = wave >> 1, wn = wave & 1, c = lane & 15, g = lane >> 4;
  const bf16_t* wt = (const bf16_t*)(p.ws + W_WTOUT) + (size_t)layer * 1024 * 1024;
  const int ntiles = 64 * 8;
  for (int t = blockIdx.x; t < ntiles; t += gridDim.x) {
    const int m0 = (t % 64) * 160, n0 = (t / 64) * 128;
    const int mb = m0 + 80 * wm, nb = n0 + 64 * wn;
    f32x4 acc[5][4];
    zero_acc<5, 4>(acc);
    gemm_mainloop_dma_sw<true>((const bf16_t*)(p.ws + W_HMOD) + (size_t)m0 * 1024, 1024, wt + (size_t)n0 * 1024, 1024, 1024, acc, smem);
#pragma unroll
    for (int mt = 0; mt < 5; ++mt) {
      const int tok = mb + 16 * mt + c;
      const float* xin = (layer == 0) ? (tok < NCTX ? p.x_prompt + (size_t)tok * 1024 : p.x_sample + (size_t)(tok - NCTX) * 1024)
                                      : p.out + (size_t)tok * 1024;
      const int v = tok < NCTX ? 0 : 1 + ((tok - NCTX) >> 10);
      const float* gate = (const float*)(p.ws + W_ADA) + (layer * 3 + v) * 3072 + 2048;
      float* xo = p.out + (size_t)tok * 1024;
#pragma unroll
      for (int nt = 0; nt < 4; ++nt) {
        const int col = nb + 32 * (nt >> 1) + 8 * g + 4 * (nt & 1);
        f32x4 xv = *(const f32x4*)(xin + col);
        f32x4 gv = *(const f32x4*)(gate + col);
        *(f32x4*)(xo + col) = xv + gv * acc[mt][nt];
      }
    }
  }
}

__device__ __forceinline__ void phase_final(const Params& p) {
  const int lane = get_tid() & 63, wave = __builtin_amdgcn_readfirstlane(get_tid() >> 6);
  const int gw = blockIdx.x * 4 + wave, nw = gridDim.x * 4;
  for (int row = gw; row < MTOK; row += nw) {
    float* x = p.out + (size_t)row * 1024;
    float4 xv[4];
    float ss = 0.f;
#pragma unroll
    for (int i = 0; i < 4; ++i) {
      xv[i] = *(const float4*)(x + (i * 64 + lane) * 4);
      ss += xv[i].x * xv[i].x + xv[i].y * xv[i].y + xv[i].z * xv[i].z + xv[i].w * xv[i].w;
    }
    ss = wave_sum(ss);
    const float rstd = rsqrtf(ss * (1.f / 1024.f) + EPS);
#pragma unroll
    for (int i = 0; i < 4; ++i) {
      int col = (i * 64 + lane) * 4;
      float4 g = *(const float4*)(p.final_g + col);
      float4 r;
      r.x = xv[i].x * rstd * g.x; r.y = xv[i].y * rstd * g.y; r.z = xv[i].z * rstd * g.z; r.w = xv[i].w * rstd * g.w;
      *(float4*)(x + col) = r;
    }
  }
}

#define XB_TMO      128
#define XB_XCNT(j)  (256  + 64 * (j))
#define XB_XSUB(j)  (1280 + 64 * (j))
#define XB_XGEN(j)  (2304 + 64 * (j))
#define XB_TOP      3328
#define XB_TOPGEN   3392
#define XCD_BAR_WORDS 3456
#define XB_SPIN_CAP (1u << 22)
#define LAS __attribute__((address_space(3)))
DI unsigned xb_ld(unsigned* p) { return __hip_atomic_load(p, __ATOMIC_RELAXED, __HIP_MEMORY_SCOPE_AGENT); }
DI unsigned xb_add(unsigned* p, unsigned v) { return __hip_atomic_fetch_add(p, v, __ATOMIC_RELAXED, __HIP_MEMORY_SCOPE_AGENT); }
DI unsigned xb_xcc_id() { return (unsigned)__builtin_amdgcn_s_getreg((3 << 11) | 20) & 0xFu; }
#define XB_SPIN(cond, bar) do { unsigned _sp = 0; while (cond) { __builtin_amdgcn_s_sleep(1); \
    if ((++_sp & 255u) == 0u) { if (xb_ld(&(bar)[XB_TMO])) break; if (_sp > XB_SPIN_CAP) { atomicAdd(&(bar)[XB_TMO], 1u); break; } } } } while (0)
struct XcdBarrier { unsigned* bar; unsigned x; volatile LAS unsigned* st; };
DI XcdBarrier xcd_barrier_post(unsigned* bar, volatile LAS unsigned* st) {
  XcdBarrier b; b.bar = bar; b.x = xb_xcc_id(); b.st = st;
  if (threadIdx.x == 0) (void)xb_add(&bar[XB_XCNT(b.x)], 1u);
  return b;
}
DI void xcd_barrier_complete(unsigned* bar, unsigned x, unsigned& nloc, unsigned& nx) {
  const unsigned G = gridDim.x * gridDim.y * gridDim.z;
  unsigned sum, cnt, mine, sp = 0u;
  for (;;) {
    sum = 0u; cnt = 0u; mine = 0u;
#pragma unroll
    for (unsigned j = 0; j < 16; ++j) { const unsigned c = xb_ld(&bar[XB_XCNT(j)]); sum += c; cnt += (c > 0u) ? 1u : 0u; mine = (j == x) ? c : mine; }
    if (sum == G) break;
    __builtin_amdgcn_s_sleep(1);
    if ((++sp & 255u) == 0u) { if (xb_ld(&bar[XB_TMO])) break; if (sp > XB_SPIN_CAP) { atomicAdd(&bar[XB_TMO], 1u); break; } }
  }
  nloc = mine > 0u ? mine : 1u; nx = cnt > 0u ? cnt : 1u;
}
DI void xcd_barrier(const XcdBarrier& b) {
  asm volatile("s_waitcnt vmcnt(0)" ::: "memory");
  __syncthreads();
  if (threadIdx.x == 0) {
    unsigned* bar = b.bar;
    __builtin_amdgcn_s_waitcnt(0);
    unsigned nloc = b.st[0], nx = b.st[1];
    if (nloc == 0u) { xcd_barrier_complete(bar, b.x, nloc, nx); b.st[0] = nloc; b.st[1] = nx; }
    const unsigned old = xb_add(&bar[XB_XSUB(b.x)], 1u);
    const unsigned gen = old / nloc;
    if (old + 1u == (gen + 1u) * nloc) {
      __builtin_amdgcn_fence(__ATOMIC_RELEASE, "agent");
      asm volatile("s_waitcnt vmcnt(0)" ::: "memory");
      const unsigned og = xb_add(&bar[XB_TOP], 1u);
      const unsigned tg = og / nx;
      if (og + 1u == (tg + 1u) * nx) xb_add(&bar[XB_TOPGEN], 1u);
      else XB_SPIN(xb_ld(&bar[XB_TOPGEN]) == tg, bar);
      __builtin_amdgcn_fence(__ATOMIC_ACQUIRE, "agent");
      xb_add(&bar[XB_XGEN(b.x)], 1u);
      asm volatile("s_waitcnt vmcnt(0)" ::: "memory");
    } else {
      XB_SPIN(xb_ld(&bar[XB_XGEN(b.x)]) == gen, bar);
      __builtin_amdgcn_fence(__ATOMIC_ACQUIRE, "agent");
      asm volatile("s_waitcnt vmcnt(0)" ::: "memory");
    }
  }
  __syncthreads();
}

#if MULTI_LAUNCH
constexpr int NPHASE = 16;
DI void run_phase(const Params& p, int ph, char* smem) {
  if (ph == 0) { phase_prep(p, smem, 0, blockIdx.x, gridDim.x); phase_prep(p, smem, 1, blockIdx.x, gridDim.x); return; }
  if (ph == 15) { phase_final(p); return; }
  const int layer = (ph - 1) / 7, s = (ph - 1) % 7;
  switch (s) {
    case 0: phase_hmod(p, layer); break;
    case 1: phase_inproj(p, layer, smem); break;
    case 2: phase_mixers(p, layer, smem); break;
    case 3: phase_ssd_scan(p, layer); break;
    case 4: phase_ssd_final(p, layer, smem); break;
    case 5: phase_branch(p, layer, smem); break;
    default: phase_outproj(p, layer, smem); break;
  }
}
#endif

__global__ void __launch_bounds__(256, 2) mega_kernel(Params p) {
  __shared__ __attribute__((aligned(16))) char smem[SMEM_BYTES];
  __shared__ u32x4 xb_words;
  if (threadIdx.x == 0) xb_words = (u32x4){0u, 0u, 0u, 0u};
  __syncthreads();
  XcdBarrier xb = xcd_barrier_post((unsigned*)(p.ws + W_BAR), (volatile LAS unsigned*)&xb_words);
  if (p.ws == nullptr) cg::this_grid().sync();
  phase_prep(p, smem, 0, blockIdx.x, gridDim.x);
  xcd_barrier(xb);
#define LAYER_BODY(layer) \
    phase_hmod(p, layer); \
    xcd_barrier(xb); \
    phase_inproj(p, layer, smem); \
    xcd_barrier(xb); \
    phase_mixers(p, layer, smem); \
    xcd_barrier(xb); \
    phase_ssd_scan(p, layer); \
    xcd_barrier(xb); \
    phase_ssd_final(p, layer, smem); \
    if (layer == 0) { \
      const int nidle = (int)gridDim.x - 320; \
      if (nidle > 0) { \
        if ((int)blockIdx.x >= 320) phase_prep(p, smem, 1, blockIdx.x - 320, nidle, 0, 11 * nidle); \
        else phase_prep(p, smem, 1, blockIdx.x, 320, 11 * nidle, N_DEF); \
      } else phase_prep(p, smem, 1, blockIdx.x, gridDim.x); \
    } \
    xcd_barrier(xb); \
    phase_branch(p, layer, smem); \
    xcd_barrier(xb); \
    phase_outproj(p, layer, smem); \
    xcd_barrier(xb);
  LAYER_BODY(0)
  LAYER_BODY(1)
#undef LAYER_BODY
  phase_final(p);
}

#if MULTI_LAUNCH
__global__ void __launch_bounds__(256, 2) phase_kernel(Params p, int ph) {
  __shared__ __attribute__((aligned(16))) char smem[SMEM_BYTES];
  run_phase(p, ph, smem);
}
#endif

extern "C" void kernel_launch(void* const* d_in, const int* in_sizes, int n_in, void* d_out, int out_size, void* d_ws,
                              size_t ws_size, hipStream_t stream) {
  Params p{};
  const float** pp = (const float**)&p;
  for (int i = 0; i < 30; ++i) pp[i] = (const float*)d_in[i];
  p.out = (float*)d_out;
  p.ws = (char*)d_ws;
  if (ws_size < W_END) { fprintf(stderr, "workspace too small: %zu < %zu\n", ws_size, (size_t)W_END); return; }
#if MULTI_LAUNCH
  for (int ph = 0; ph < NPHASE; ++ph) hipLaunchKernelGGL(phase_kernel, dim3(512), dim3(256), 0, stream, p, ph);
#else
  static int grid_blocks = 0;
  if (!grid_blocks) {
    int dev = 0, cus = 0, per_cu = 0;
    hipGetDevice(&dev);
    hipDeviceGetAttribute(&cus, hipDeviceAttributeMultiprocessorCount, dev);
    hipOccupancyMaxActiveBlocksPerMultiprocessor(&per_cu, mega_kernel, 256, 0);
    if (per_cu > 2) per_cu = 2;
    grid_blocks = cus * per_cu;
  }
  (void)hipMemsetAsync((char*)d_ws + W_BAR, 0, 16384, stream);
  void* args[] = {&p};
  hipError_t e = hipLaunchCooperativeKernel((void*)mega_kernel, dim3(grid_blocks), dim3(256), args, 0, stream);
  if (e != hipSuccess) fprintf(stderr, "cooperative launch failed: %s (grid %d)\n", hipGetErrorString(e), grid_blocks);
#endif
}
```

```cpp
#include <hip/hip_runtime.h>
#include <hip/hip_cooperative_groups.h>
#include <stdint.h>
#include <stdio.h>
namespace cg = cooperative_groups;

#ifndef MULTI_LAUNCH
#define MULTI_LAUNCH 0
#endif

#define DI __device__ __forceinline__
typedef unsigned short bf16_t;
typedef short bf16x8 __attribute__((ext_vector_type(8)));
typedef float f32x4 __attribute__((ext_vector_type(4)));
typedef unsigned u32x4 __attribute__((ext_vector_type(4)));
typedef unsigned u32x2 __attribute__((ext_vector_type(2)));

constexpr int DM = 1024;
constexpr int NCTX = 8192;
constexpr int NLAT = 2048;
constexpr int MTOK = NCTX + NLAT;
constexpr int INC = 8464;
constexpr int NPAD = 8576;
constexpr int LDP = 7424;
constexpr int PC_QA = 0, PC_KA = 512, PC_GA = 1024, PC_Z = 1536, PC_XBC = 2048, PC_QC = 2816, PC_KC = 3328, PC_GC = 3840, PC_MG = 4352;
constexpr float EPS = 1e-6f;

constexpr size_t O_YP = 0;
constexpr size_t O_DK = 10485760;
constexpr size_t O_DV = 18874368;
constexpr size_t O_NK = 27262976;
constexpr size_t O_NV = 35651584;
constexpr size_t O_SS = 44040192;

constexpr size_t W_WTIN = 0;
constexpr size_t W_WTBR = W_WTIN + (size_t)2 * NPAD * 1024 * 2;
constexpr size_t W_WTOUT = W_WTBR + (size_t)2 * 3 * 1024 * 512 * 2;
constexpr size_t W_CKA = W_WTOUT + (size_t)2 * 1024 * 1024 * 2;
constexpr size_t W_CVTA = W_CKA + 2097152;
constexpr size_t W_CKC = W_CVTA + 2097152;
constexpr size_t W_CVTC = W_CKC + 2097152;
constexpr size_t W_ADA = W_CVTC + 2097152;
constexpr size_t W_ROPE = W_ADA + 73728;
constexpr size_t W_LAM = W_ROPE + 8192;
constexpr size_t W_PARTS = W_LAM + 256;
constexpr size_t W_VAT = W_PARTS + (size_t)MTOK * LDP * 2;
constexpr size_t W_VCT = W_VAT + (size_t)512 * MTOK * 2;
constexpr size_t W_DT = W_VCT + (size_t)512 * MTOK * 2;
constexpr size_t W_HMOD = W_DT + (size_t)MTOK * 16 * 4;
constexpr size_t W_YBF = W_HMOD + (size_t)MTOK * 1024 * 2;
constexpr size_t W_YBB = W_YBF + (size_t)MTOK * 512 * 2;
constexpr size_t W_BAR = W_YBB + (size_t)MTOK * 512 * 2;
constexpr size_t W_EA = W_BAR + 16384;
constexpr size_t W_CC = W_EA + (size_t)MTOK * 16 * 4;
constexpr size_t W_RSTD = W_CC + (size_t)MTOK * 128 * 2;
constexpr size_t W_END = W_RSTD + (size_t)MTOK * 4;

constexpr int SMEM_BYTES = 73728;
constexpr int LS = 72;

struct Params {
  const float *x_prompt, *x_sample, *cache_dk, *cache_dv, *cache_nk, *cache_nv, *state_ssd, *cvec, *c_ctx;
  const float *norm_g, *w_ada, *b_ada, *w_in, *lam_q1, *lam_k1, *lam_q2, *lam_k2, *subln_g, *conv_w, *conv_b;
  const float *dt_bias, *a_log, *d_skip, *ssd_norm_g, *na_rpb, *w_br_a, *w_br_b, *w_br_c, *w_out, *final_g;
  float* out;
  char* ws;
};

DI bf16_t f2bf(float x) { unsigned u = __float_as_uint(x); u += 0x7fffu + ((u >> 16) & 1u); return (bf16_t)(u >> 16); }
DI float bf2f(bf16_t h) { return __uint_as_float(((unsigned)h) << 16); }
DI unsigned pack2(float a, float b) { return (unsigned)f2bf(a) | ((unsigned)f2bf(b) << 16); }
DI float bflo(unsigned u) { return __uint_as_float(u << 16); }
DI float bfhi(unsigned u) { return __uint_as_float(u & 0xffff0000u); }
DI float siluf(float x) { return x / (1.f + __expf(-x)); }
DI float sigmf(float x) { return 1.f / (1.f + __expf(-x)); }
DI float wave_sum(float v) {
#pragma unroll
  for (int o = 32; o > 0; o >>= 1) v += __shfl_xor(v, o);
  return v;
}
DI void unpack8(const u32x4& v, float* f) {
  f[0] = bflo(v.x); f[1] = bfhi(v.x); f[2] = bflo(v.y); f[3] = bfhi(v.y);
  f[4] = bflo(v.z); f[5] = bfhi(v.z); f[6] = bflo(v.w); f[7] = bfhi(v.w);
}
DI f32x4 mfma16(bf16x8 a, bf16x8 b, f32x4 c) { return __builtin_amdgcn_mfma_f32_16x16x32_bf16(a, b, c, 0, 0, 0); }
DI bf16x8 lds_frag(const bf16_t* s, int row, int k) { return *(const bf16x8*)(s + row * LS + k); }
DI int get_tid() { int t = threadIdx.x; asm volatile("" : "+v"(t)); return t; }
DI float lam_init_of(int layer) { return layer == 0 ? 0.2f : (0.8f - 0.6f * 0.7408182206817179f); }

DI void transpose_tile(const float* __restrict__ src, int ld, int R0, int C0, int Cmax, bf16_t* __restrict__ dst, int ld_dst,
                       bool perm_in, float* tile) {
  const int tid = get_tid();
#pragma unroll
  for (int i = 0; i < 4; ++i) {
    int idx = tid + 256 * i, r = idx >> 4, c4 = (idx & 15) * 4;
    f32x4 v = (f32x4){0.f, 0.f, 0.f, 0.f};
    if (C0 + c4 < Cmax) v = __builtin_nontemporal_load((const f32x4*)(src + (size_t)(R0 + r) * ld + C0 + c4));
    float* t = tile + r * 65 + c4;
    t[0] = v[0]; t[1] = v[1]; t[2] = v[2]; t[3] = v[3];
  }
  __syncthreads();
#pragma unroll
  for (int i = 0; i < 2; ++i) {
    int idx = tid + 256 * i, cc = idx >> 3, kc = (idx & 7) * 8;
    int n = C0 + cc;
    if (n < Cmax) {
      int nrow = n;
      if (perm_in) nrow = (n < 3328) ? n : (n < 3344 ? 8448 + (n - 3328) : n - 16);
      u32x4 w;
      w.x = pack2(tile[(kc + 0) * 65 + cc], tile[(kc + 1) * 65 + cc]);
      w.y = pack2(tile[(kc + 2) * 65 + cc], tile[(kc + 3) * 65 + cc]);
      w.z = pack2(tile[(kc + 4) * 65 + cc], tile[(kc + 5) * 65 + cc]);
      w.w = pack2(tile[(kc + 6) * 65 + cc], tile[(kc + 7) * 65 + cc]);
      *(u32x4*)(dst + (size_t)nrow * ld_dst + R0 + kc) = w;
    }
  }
  __syncthreads();
}

constexpr int J_ADA = 192;
constexpr int J_WIN = J_ADA + 2 * 16 * 133;
constexpr int J_WBR = J_WIN + 768;
constexpr int J_WOUT = J_WBR + 512;
constexpr int J_CV = J_WOUT + 512;
constexpr int J_CK = J_CV + 512;
constexpr int J_MISC = J_CK + 1;

constexpr int J_DEF0 = J_ADA + 16 * 133, J_DEF1 = J_WOUT, N_DEF = J_DEF1 - J_DEF0;
__device__ __forceinline__ void phase_prep(const Params& p, char* smem, int mode, int first, int stride, int lo = 0, int hi = 1 << 30) {
  const int tid = get_tid();
  float* fs = (float*)smem;
  const int njobs = min(hi, mode == 0 ? J_MISC - N_DEF : N_DEF);
  for (int idx = lo + first; idx < njobs; idx += stride) {
    const int job = mode == 0 ? (idx < J_DEF0 ? idx : idx + N_DEF) : J_DEF0 + idx;
    if (job < J_ADA) {
      const int l = job / 96, jg = job % 96;
      float* sv = fs;
      float* red = fs + 3072;
      for (int i = tid; i < 3072; i += 256) {
        int v = i >> 10, k = i & 1023;
        float x = (v == 0) ? p.c_ctx[k] : p.cvec[(v - 1) * 1024 + k];
        sv[i] = siluf(x);
      }
      __syncthreads();
      const int kq = tid >> 5, jj = tid & 31;
      const float* w = p.w_ada + (size_t)l * 1024 * 3072 + jg * 32 + jj;
      float a0 = 0.f, a1 = 0.f, a2 = 0.f;
#pragma unroll 8
      for (int k = kq * 128; k < kq * 128 + 128; ++k) {
        float wv = w[(size_t)k * 3072];
        a0 += sv[k] * wv; a1 += sv[1024 + k] * wv; a2 += sv[2048 + k] * wv;
      }
      red[(kq * 3 + 0) * 32 + jj] = a0; red[(kq * 3 + 1) * 32 + jj] = a1; red[(kq * 3 + 2) * 32 + jj] = a2;
      __syncthreads();
      if (tid < 96) {
        int v = tid >> 5, j2 = tid & 31;
        float s = 0.f;
#pragma unroll
        for (int q = 0; q < 8; ++q) s += red[(q * 3 + v) * 32 + j2];
        int col = jg * 32 + j2;
        s += p.b_ada[l * 3072 + col];
        ((float*)(p.ws + W_ADA))[(l * 3 + v) * 3072 + col] = s;
      }
      __syncthreads();
    } else if (job < J_WIN) {
      int j = job - J_ADA; int l = j / (16 * 133); j %= (16 * 133);
      int rt = j / 133, ct = j % 133;
      transpose_tile(p.w_in + (size_t)l * 1024 * INC, INC, rt * 64, ct * 64, INC,
                     (bf16_t*)(p.ws + W_WTIN) + (size_t)l * NPAD * 1024, 1024, true, fs);
    } else if (job < J_WBR) {
      int j = job - J_WIN; int lb = j / 128; j %= 128;
      int l = lb / 3, br = lb % 3;
      int rt = j / 16, ct = j % 16;
      const float* src = (br == 0 ? p.w_br_a : (br == 1 ? p.w_br_b : p.w_br_c)) + (size_t)l * 512 * 1024;
      transpose_tile(src, 1024, rt * 64, ct * 64, 1024, (bf16_t*)(p.ws + W_WTBR) + (size_t)lb * 1024 * 512, 512, false, fs);
    } else if (job < J_WOUT) {
      int j = job - J_WBR; int l = j / 256; j %= 256;
      int rt = j / 16, ct = j % 16;
      transpose_tile(p.w_out + (size_t)l * 1024 * 1024, 1024, rt * 64, ct * 64, 1024,
                     (bf16_t*)(p.ws + W_WTOUT) + (size_t)l * 1024 * 1024, 1024, false, fs);
    } else if (job < J_CV) {
      int j = job - J_WOUT; int which = j / 256; j %= 256;
      int bl = j / 64; j %= 64;
      int rt = j / 8, ct = j % 8;
      const float* src = (which == 0 ? p.cache_dv : p.cache_nv) + (size_t)bl * 512 * 512;
      bf16_t* dst = (bf16_t*)(p.ws + (which == 0 ? W_CVTA : W_CVTC)) + (size_t)bl * 512 * 512;
      transpose_tile(src, 512, rt * 64, ct * 64, 512, dst, 512, false, fs);
    } else if (job < J_CK) {
      int j = job - J_CV; int which = j / 256; j %= 256;
      const float* src = (which == 0 ? p.cache_dk : p.cache_nk) + (size_t)j * 4096;
      bf16_t* dst = (bf16_t*)(p.ws + (which == 0 ? W_CKA : W_CKC)) + (size_t)j * 4096;
#pragma unroll
      for (int i = 0; i < 2; ++i) {
        int e = (tid + 256 * i) * 8;
        float4 a = *(const float4*)(src + e), b = *(const float4*)(src + e + 4);
        u32x4 w; w.x = pack2(a.x, a.y); w.y = pack2(a.z, a.w); w.z = pack2(b.x, b.y); w.w = pack2(b.z, b.w);
        *(u32x4*)(dst + e) = w;
      }
    } else {
      float2* rope = (float2*)(p.ws + W_ROPE);
      for (int i = tid; i < 1024; i += 256) {
        int pos = i >> 4, fi = i & 15;
        float inv = exp2f(-(float)fi * (13.287712379549449f / 16.f));
        float ang = (float)pos * inv;
        rope[i] = make_float2(cosf(ang), sinf(ang));
      }
      if (tid < 2) {
        int l = tid;
        float s1 = 0.f, s2 = 0.f;
        for (int k = 0; k < 64; ++k) {
          s1 += p.lam_q1[l * 64 + k] * p.lam_k1[l * 64 + k];
          s2 += p.lam_q2[l * 64 + k] * p.lam_k2[l * 64 + k];
        }
        ((float*)(p.ws + W_LAM))[l] = expf(s1) - expf(s2) + lam_init_of(l);
      }
    }
  }
}

__device__ __forceinline__ void phase_hmod(const Params& p, int layer) {
  const int lane = get_tid() & 63, wave = __builtin_amdgcn_readfirstlane(get_tid() >> 6);
  const int gw = blockIdx.x * 4 + wave, nw = gridDim.x * 4;
  bf16_t* hm = (bf16_t*)(p.ws + W_HMOD);
  const float* ng = p.norm_g + layer * 1024;
  f32x4 xn[4];
  {
    const int row = min(gw, MTOK - 1);
    const float* x = (layer == 0) ? (row < NCTX ? p.x_prompt + (size_t)row * 1024 : p.x_sample + (size_t)(row - NCTX) * 1024)
                                  : p.out + (size_t)row * 1024;
#pragma unroll
    for (int i = 0; i < 4; ++i) xn[i] = *(const f32x4*)(x + (i * 64 + lane) * 4);
  }
  for (int row = gw; row < MTOK; row += nw) {
    const int v = row < NCTX ? 0 : 1 + ((row - NCTX) >> 10);
    const float* ada = (const float*)(p.ws + W_ADA) + (layer * 3 + v) * 3072;
    float4 xv[4];
    float ss = 0.f;
#pragma unroll
    for (int i = 0; i < 4; ++i) {
      xv[i] = make_float4(xn[i][0], xn[i][1], xn[i][2], xn[i][3]);
      ss += xv[i].x * xv[i].x + xv[i].y * xv[i].y + xv[i].z * xv[i].z + xv[i].w * xv[i].w;
    }
    {
      const int rn = min(row + nw, MTOK - 1);
      const float* x2 = (layer == 0) ? (rn < NCTX ? p.x_prompt + (size_t)rn * 1024 : p.x_sample + (size_t)(rn - NCTX) * 1024)
                                     : p.out + (size_t)rn * 1024;
#pragma unroll
      for (int i = 0; i < 4; ++i) xn[i] = *(const f32x4*)(x2 + (i * 64 + lane) * 4);
    }
    ss = wave_sum(ss);
    const float rstd = rsqrtf(ss * (1.f / 1024.f) + EPS);
#pragma unroll
    for (int i = 0; i < 4; ++i) {
      int col = (i * 64 + lane) * 4;
      float4 g = *(const float4*)(ng + col);
      float4 sh = *(const float4*)(ada + col);
      float4 sc = *(const float4*)(ada + 1024 + col);
      float h0 = xv[i].x * rstd * g.x * (1.f + sc.x) + sh.x;
      float h1 = xv[i].y * rstd * g.y * (1.f + sc.y) + sh.y;
      float h2 = xv[i].z * rstd * g.z * (1.f + sc.z) + sh.z;
      float h3 = xv[i].w * rstd * g.w * (1.f + sc.w) + sh.w;
      u32x2 w; w.x = pack2(h0, h1); w.y = pack2(h2, h3);
      *(u32x2*)(hm + (size_t)row * 1024 + col) = w;
    }
  }
}

template <int MT, int NT, int DEPTH, bool PERMB = false>
DI void gemm_mainloop(const bf16_t* __restrict__ Ag, int lda, const bf16_t* __restrict__ Bg, int ldb, int K,
                      f32x4 (&acc)[MT][NT], bf16_t* sA, bf16_t* sB) {
  const int tid = get_tid(), lane = tid & 63, wave = __builtin_amdgcn_readfirstlane(tid >> 6), wm = wave >> 1, wn = wave & 1, c = lane & 15, g = lane >> 4;
  u32x4 ra0[MT], rb0[NT], ra1[MT], rb1[NT];
  const int lr = tid >> 3, lk = (tid & 7) * 8;
  const int lrb = PERMB ? 16 * ((lr >> 2) & 1) + 4 * ((lr >> 3) & 3) + (lr & 3) : lr;
  const bf16_t* ap = Ag + (size_t)lr * lda + lk;
  const bf16_t* bp = Bg + (size_t)lr * ldb + lk;
#define GLOAD(RA, RB, K0) { _Pragma("unroll") for (int i = 0; i < MT; ++i) RA[i] = *(const u32x4*)(ap + (size_t)(32 * i) * lda + (K0)); \
                            _Pragma("unroll") for (int i = 0; i < NT; ++i) RB[i] = *(const u32x4*)(bp + (size_t)(32 * i) * ldb + (K0)); }
#define LSTORE(RA, RB) { _Pragma("unroll") for (int i = 0; i < MT; ++i) *(u32x4*)(sA + (lr + 32 * i) * LS + lk) = RA[i]; \
                         _Pragma("unroll") for (int i = 0; i < NT; ++i) *(u32x4*)(sB + (lrb + 32 * i) * LS + lk) = RB[i]; }
#define COMPUTE() { _Pragma("unroll") for (int ks = 0; ks < 2; ++ks) { bf16x8 xf[MT], wf[NT]; \
      _Pragma("unroll") for (int t = 0; t < MT; ++t) xf[t] = lds_frag(sA, 16 * MT * wm + 16 * t + c, 32 * ks + 8 * g); \
      _Pragma("unroll") for (int t = 0; t < NT; ++t) wf[t] = lds_frag(sB, 16 * NT * wn + 16 * t + c, 32 * ks + 8 * g); \
      _Pragma("unroll") for (int mt = 0; mt < MT; ++mt) _Pragma("unroll") for (int nt = 0; nt < NT; ++nt) acc[mt][nt] = mfma16(wf[nt], xf[mt], acc[mt][nt]); } }
  const int nk = K >> 6;
  if (DEPTH == 2) {
    GLOAD(ra0, rb0, 0);
    GLOAD(ra1, rb1, 64);
    for (int kt = 0; kt < nk; kt += 2) {
      __syncthreads();
      LSTORE(ra0, rb0);
      __syncthreads();
      if (kt + 2 < nk) GLOAD(ra0, rb0, (kt + 2) << 6);
      COMPUTE();
      __syncthreads();
      LSTORE(ra1, rb1);
      __syncthreads();
      if (kt + 3 < nk) GLOAD(ra1, rb1, (kt + 3) << 6);
      COMPUTE();
    }
  } else {
    GLOAD(ra0, rb0, 0);
    for (int kt = 0; kt < nk; ++kt) {
      __syncthreads();
      LSTORE(ra0, rb0);
      __syncthreads();
      if (kt + 1 < nk) GLOAD(ra0, rb0, (kt + 1) << 6);
      COMPUTE();
    }
  }
#undef GLOAD
#undef LSTORE
#undef COMPUTE
}

template <int MT, int NT>
DI void zero_acc(f32x4 (&acc)[MT][NT]) {
#pragma unroll
  for (int a = 0; a < MT; ++a)
#pragma unroll
    for (int b = 0; b < NT; ++b) acc[a][b] = (f32x4){0.f, 0.f, 0.f, 0.f};
}

DI void lds_read_frags(bf16x8 (&x)[4], bf16x8 (&w)[4], unsigned aA, unsigned aB, int ks) {
  if (ks == 0)
    asm volatile("ds_read_b128 %0, %8\n\tds_read_b128 %1, %8 offset:2304\n\tds_read_b128 %2, %8 offset:4608\n\tds_read_b128 %3, %8 offset:6912\n\t"
                 "ds_read_b128 %4, %9\n\tds_read_b128 %5, %9 offset:2304\n\tds_read_b128 %6, %9 offset:4608\n\tds_read_b128 %7, %9 offset:6912\n\t"
                 "s_waitcnt lgkmcnt(0)"
                 : "=&v"(x[0]), "=&v"(x[1]), "=&v"(x[2]), "=&v"(x[3]), "=&v"(w[0]), "=&v"(w[1]), "=&v"(w[2]), "=&v"(w[3])
                 : "v"(aA), "v"(aB) : "memory");
  else
    asm volatile("ds_read_b128 %0, %8 offset:64\n\tds_read_b128 %1, %8 offset:2368\n\tds_read_b128 %2, %8 offset:4672\n\tds_read_b128 %3, %8 offset:6976\n\t"
                 "ds_read_b128 %4, %9 offset:64\n\tds_read_b128 %5, %9 offset:2368\n\tds_read_b128 %6, %9 offset:4672\n\tds_read_b128 %7, %9 offset:6976\n\t"
                 "s_waitcnt lgkmcnt(0)"
                 : "=&v"(x[0]), "=&v"(x[1]), "=&v"(x[2]), "=&v"(x[3]), "=&v"(w[0]), "=&v"(w[1]), "=&v"(w[2]), "=&v"(w[3])
                 : "v"(aA), "v"(aB) : "memory");
}
DI void lds_read_frags(bf16x8 (&x)[5], bf16x8 (&w)[2], unsigned aA, unsigned aB, int ks) {
  if (ks == 0)
    asm volatile("ds_read_b128 %0, %7\n\tds_read_b128 %1, %7 offset:2304\n\tds_read_b128 %2, %7 offset:4608\n\tds_read_b128 %3, %7 offset:6912\n\tds_read_b128 %4, %7 offset:9216\n\t"
                 "ds_read_b128 %5, %8\n\tds_read_b128 %6, %8 offset:2304\n\t"
                 "s_waitcnt lgkmcnt(0)"
                 : "=&v"(x[0]), "=&v"(x[1]), "=&v"(x[2]), "=&v"(x[3]), "=&v"(x[4]), "=&v"(w[0]), "=&v"(w[1])
                 : "v"(aA), "v"(aB) : "memory");
  else
    asm volatile("ds_read_b128 %0, %7 offset:64\n\tds_read_b128 %1, %7 offset:2368\n\tds_read_b128 %2, %7 offset:4672\n\tds_read_b128 %3, %7 offset:6976\n\tds_read_b128 %4, %7 offset:9280\n\t"
                 "ds_read_b128 %5, %8 offset:64\n\tds_read_b128 %6, %8 offset:2368\n\t"
                 "s_waitcnt lgkmcnt(0)"
                 : "=&v"(x[0]), "=&v"(x[1]), "=&v"(x[2]), "=&v"(x[3]), "=&v"(x[4]), "=&v"(w[0]), "=&v"(w[1])
                 : "v"(aA), "v"(aB) : "memory");
}

DI void lds_issue_frags1(bf16x8 (&x)[4], bf16x8 (&w)[4], unsigned aA, unsigned aB) {
  asm volatile("ds_read_b128 %0, %8 offset:64\n\tds_read_b128 %1, %8 offset:2368\n\tds_read_b128 %2, %8 offset:4672\n\tds_read_b128 %3, %8 offset:6976\n\t"
               "ds_read_b128 %4, %9 offset:64\n\tds_read_b128 %5, %9 offset:2368\n\tds_read_b128 %6, %9 offset:4672\n\tds_read_b128 %7, %9 offset:6976"
               : "=&v"(x[0]), "=&v"(x[1]), "=&v"(x[2]), "=&v"(x[3]), "=&v"(w[0]), "=&v"(w[1]), "=&v"(w[2]), "=&v"(w[3])
               : "v"(aA), "v"(aB) : "memory");
}
DI void lds_wait_frags(bf16x8 (&x)[4], bf16x8 (&w)[4], f32x4& a0, f32x4& a1, f32x4& a2, f32x4& a3) {
  asm volatile("s_waitcnt lgkmcnt(0)"
               : "+v"(x[0]), "+v"(x[1]), "+v"(x[2]), "+v"(x[3]), "+v"(w[0]), "+v"(w[1]), "+v"(w[2]), "+v"(w[3]),
                 "+v"(a0), "+v"(a1), "+v"(a2), "+v"(a3) :: "memory");
}
DI void lds_issue_frags1(bf16x8 (&x)[5], bf16x8 (&w)[2], unsigned aA, unsigned aB) { lds_read_frags(x, w, aA, aB, 1); }
DI void lds_wait_frags(bf16x8 (&x)[5], bf16x8 (&w)[2], f32x4& a0, f32x4& a1, f32x4& a2, f32x4& a3) {}

template <int MT, int NT, bool PERMB = false>
DI void gemm_mainloop_dma(const bf16_t* __restrict__ Ag, int lda, const bf16_t* __restrict__ Bg, int ldb, int K,
                          f32x4 (&acc)[MT][NT], char* smem) {
  constexpr int RA = 32 * MT, RB = 32 * NT, ROWS = RA + RB, NCH = ROWS * 9, NI = (NCH + 255) / 256, BUF = NI * 4096;
  static_assert(2 * BUF <= SMEM_BYTES, "LDS");
  const int tid = get_tid(), lane = tid & 63, wave = __builtin_amdgcn_readfirstlane(tid >> 6), wm = wave >> 1, wn = wave & 1, c = lane & 15, g = lane >> 4;
  const bf16_t* src[NI];
#pragma unroll
  for (int i = 0; i < NI; ++i) {
    const int q = tid + 256 * i;
    int row = q / 9, cc = q - row * 9;
    row = min(row, ROWS - 1); cc = min(cc, 7);
    int rb = row - RA;
    if (PERMB) { const int t = (rb >> 4) & 3, c4 = rb & 15; rb = (rb & ~63) + 32 * (t >> 1) + 8 * (c4 >> 2) + 4 * (t & 1) + (c4 & 3); }
    src[i] = (row < RA ? Ag + (size_t)row * lda : Bg + (size_t)rb * ldb) + cc * 8;
  }
#define DMA_ISSUE(KT, BUFI) { _Pragma("unroll") for (int i = 0; i < NI; ++i) \
    __builtin_amdgcn_global_load_lds((const unsigned*)(src[i] + ((KT) << 6)), (unsigned*)(smem + (BUFI) * BUF + (tid + 256 * i) * 16), 16, 0, 0); }
  const int nk = K >> 6;
  const unsigned ldsA = (unsigned)(size_t)smem + (unsigned)((16 * MT * wm + c) * (LS * 2) + 16 * g);
  const unsigned ldsB = (unsigned)(size_t)smem + (unsigned)((RA + 16 * NT * wn + c) * (LS * 2) + 16 * g);
  __syncthreads();
  DMA_ISSUE(0, 0);
  asm volatile("s_waitcnt vmcnt(0)" ::: "memory");
  __syncthreads();
  for (int kt = 0; kt < nk; ++kt) {
    const int cur = kt & 1;
    if (kt + 1 < nk) DMA_ISSUE(kt + 1, cur ^ 1);
    const unsigned aA = ldsA + cur * BUF, aB = ldsB + cur * BUF;
    {
      bf16x8 xf[MT], wf[NT], xg[MT], wg[NT];
      lds_read_frags(xf, wf, aA, aB, 0);
      lds_issue_frags1(xg, wg, aA, aB);
#pragma unroll
      for (int mt = 0; mt < MT; ++mt)
#pragma unroll
        for (int nt = 0; nt < NT; ++nt) acc[mt][nt] = mfma16(wf[nt], xf[mt], acc[mt][nt]);
      lds_wait_frags(xg, wg, acc[MT - 1][0], acc[MT - 1][1], acc[MT - 1][NT - 2], acc[MT - 1][NT - 1]);
#pragma unroll
      for (int mt = 0; mt < MT; ++mt)
#pragma unroll
        for (int nt = 0; nt < NT; ++nt) acc[mt][nt] = mfma16(wg[nt], xg[mt], acc[mt][nt]);
    }
    asm volatile("s_waitcnt vmcnt(0)" : "+v"(acc[0][0]), "+v"(acc[0][NT - 1]), "+v"(acc[MT - 1][0]), "+v"(acc[MT - 1][NT - 1]) :: "memory");
    __syncthreads();
  }
#undef DMA_ISSUE
}

DI void lds_read_frags_sw(bf16x8 (&x)[5], bf16x8 (&w)[4], unsigned aA, unsigned aB) {
  asm volatile("ds_read_b128 %0, %9\n\tds_read_b128 %1, %9 offset:2048\n\tds_read_b128 %2, %9 offset:4096\n\tds_read_b128 %3, %9 offset:6144\n\tds_read_b128 %4, %9 offset:8192\n\t"
               "ds_read_b128 %5, %10\n\tds_read_b128 %6, %10 offset:2048\n\tds_read_b128 %7, %10 offset:4096\n\tds_read_b128 %8, %10 offset:6144\n\t"
               "s_waitcnt lgkmcnt(0)"
               : "=&v"(x[0]), "=&v"(x[1]), "=&v"(x[2]), "=&v"(x[3]), "=&v"(x[4]), "=&v"(w[0]), "=&v"(w[1]), "=&v"(w[2]), "=&v"(w[3])
               : "v"(aA), "v"(aB) : "memory");
}
DI void lds_read_frags_sw(bf16x8 (&x)[5], bf16x8 (&w)[2], unsigned aA, unsigned aB) {
  asm volatile("ds_read_b128 %0, %7\n\tds_read_b128 %1, %7 offset:2048\n\tds_read_b128 %2, %7 offset:4096\n\tds_read_b128 %3, %7 offset:6144\n\tds_read_b128 %4, %7 offset:8192\n\t"
               "ds_read_b128 %5, %8\n\tds_read_b128 %6, %8 offset:2048\n\t"
               "s_waitcnt lgkmcnt(0)"
               : "=&v"(x[0]), "=&v"(x[1]), "=&v"(x[2]), "=&v"(x[3]), "=&v"(x[4]), "=&v"(w[0]), "=&v"(w[1])
               : "v"(aA), "v"(aB) : "memory");
}
template <bool PERMB, int NT = 4>
DI void gemm_mainloop_dma_sw(const bf16_t* __restrict__ Ag, int lda, const bf16_t* __restrict__ Bg, int ldb, int K,
                             f32x4 (&acc)[5][NT], char* smem) {
  constexpr int MT = 5, RA = 32 * MT, RB = 32 * NT, ROWS = RA + RB, NI = ROWS * 8 / 256, BUF = ROWS * 128;
  static_assert(ROWS * 8 % 256 == 0 && 2 * BUF <= SMEM_BYTES, "LDS");
  const int tid = get_tid(), lane = tid & 63, wave = __builtin_amdgcn_readfirstlane(tid >> 6), wm = wave >> 1, wn = wave & 1, c = lane & 15, g = lane >> 4;
  const bf16_t* src[NI];
#pragma unroll
  for (int i = 0; i < NI; ++i) {
    const int q = tid + 256 * i;
    const int row = q >> 3, x = (q & 7) ^ ((row >> 1) & 7);
    int rb = row - RA;
    if (PERMB && NT == 4) { const int t = (rb >> 4) & 3, c4 = rb & 15; rb = (rb & ~63) + 32 * (t >> 1) + 8 * (c4 >> 2) + 4 * (t & 1) + (c4 & 3); }
    if (PERMB && NT == 2) { const int t = (rb >> 4) & 1, c4 = rb & 15; rb = (rb & ~31) + 8 * (c4 >> 2) + 4 * t + (c4 & 3); }
    src[i] = (row < RA ? Ag + (size_t)row * lda : Bg + (size_t)rb * ldb) + x * 8;
  }
#define DMA_ISSUE(KT, BUFI) { _Pragma("unroll") for (int i = 0; i < NI; ++i) \
    __builtin_amdgcn_global_load_lds((const unsigned*)(src[i] + ((KT) << 6)), (unsigned*)(smem + (BUFI) * BUF + (tid + 256 * i) * 16), 16, 0, 0); }
  const int nk = K >> 6;
  const unsigned f = (unsigned)((c >> 1) & 7);
  const unsigned off0 = ((unsigned)g ^ f) * 16u, off1 = off0 ^ 64u;
  const unsigned rowA = (unsigned)(size_t)smem + (unsigned)((16 * MT * wm + c) * 128);
  const unsigned rowB = (unsigned)(size_t)smem + (unsigned)((RA + 16 * NT * wn + c) * 128);
  __syncthreads();
  DMA_ISSUE(0, 0);
  asm volatile("s_waitcnt vmcnt(0)" ::: "memory");
  __syncthreads();
  for (int kt = 0; kt < nk; ++kt) {
    const int cur = kt & 1;
    if (kt + 1 < nk) DMA_ISSUE(kt + 1, cur ^ 1);
    {
      bf16x8 xf[MT], wf[NT];
      lds_read_frags_sw(xf, wf, rowA + cur * BUF + off0, rowB + cur * BUF + off0);
#pragma unroll
      for (int mt = 0; mt < MT; ++mt)
#pragma unroll
        for (int nt = 0; nt < NT; ++nt) acc[mt][nt] = mfma16(wf[nt], xf[mt], acc[mt][nt]);
    }
    {
      bf16x8 xf[MT], wf[NT];
      lds_read_frags_sw(xf, wf, rowA + cur * BUF + off1, rowB + cur * BUF + off1);
#pragma unroll
      for (int mt = 0; mt < MT; ++mt)
#pragma unroll
        for (int nt = 0; nt < NT; ++nt) acc[mt][nt] = mfma16(wf[nt], xf[mt], acc[mt][nt]);
    }
    asm volatile("s_waitcnt vmcnt(0)" : "+v"(acc[0][0]), "+v"(acc[0][NT - 1]), "+v"(acc[MT - 1][0]), "+v"(acc[MT - 1][NT - 1]) :: "memory");
    __syncthreads();
  }
#undef DMA_ISSUE
}

DI void lds_read_frags_sw(bf16x8 (&x)[4], bf16x8 (&w)[4], unsigned aA, unsigned aB) {
  asm volatile("ds_read_b128 %0, %8\n\tds_read_b128 %1, %8 offset:2048\n\tds_read_b128 %2, %8 offset:4096\n\tds_read_b128 %3, %8 offset:6144\n\t"
               "ds_read_b128 %4, %9\n\tds_read_b128 %5, %9 offset:2048\n\tds_read_b128 %6, %9 offset:4096\n\tds_read_b128 %7, %9 offset:6144\n\t"
               "s_waitcnt lgkmcnt(0)"
               : "=&v"(x[0]), "=&v"(x[1]), "=&v"(x[2]), "=&v"(x[3]), "=&v"(w[0]), "=&v"(w[1]), "=&v"(w[2]), "=&v"(w[3])
               : "v"(aA), "v"(aB) : "memory");
}
DI void lds_issue_frags_sw(bf16x8 (&x)[4], bf16x8 (&w)[4], unsigned aA, unsigned aB) {
  asm volatile("ds_read_b128 %0, %8\n\tds_read_b128 %1, %8 offset:2048\n\tds_read_b128 %2, %8 offset:4096\n\tds_read_b128 %3, %8 offset:6144\n\t"
               "ds_read_b128 %4, %9\n\tds_read_b128 %5, %9 offset:2048\n\tds_read_b128 %6, %9 offset:4096\n\tds_read_b128 %7, %9 offset:6144"
               : "=&v"(x[0]), "=&v"(x[1]), "=&v"(x[2]), "=&v"(x[3]), "=&v"(w[0]), "=&v"(w[1]), "=&v"(w[2]), "=&v"(w[3])
               : "v"(aA), "v"(aB) : "memory");
}
DI void gemm_mainloop_dma_sw44(const bf16_t* __restrict__ Ag, int lda, const bf16_t* __restrict__ Bg, int ldb, int K,
                               f32x4 (&acc)[4][4], char* smem) {
  constexpr int MT = 4, NT = 4, RA = 128, ROWS = 256, NI = 8, BUF = ROWS * 128;
  const int tid = get_tid(), lane = tid & 63, wave = __builtin_amdgcn_readfirstlane(tid >> 6), wm = wave >> 1, wn = wave & 1, c = lane & 15, g = lane >> 4;
  const bf16_t* src[NI];
#pragma unroll
  for (int i = 0; i < NI; ++i) {
    const int q = tid + 256 * i;
    const int row = q >> 3, x = (q & 7) ^ ((row >> 1) & 7);
    int rb = row - RA;
    { const int t = (rb >> 4) & 3, c4 = rb & 15; rb = (rb & ~63) + 32 * (t >> 1) + 8 * (c4 >> 2) + 4 * (t & 1) + (c4 & 3); }
    src[i] = (row < RA ? Ag + (size_t)row * lda : Bg + (size_t)rb * ldb) + x * 8;
  }
#define DMA_ISSUE(KT, BUFI) { _Pragma("unroll") for (int i = 0; i < NI; ++i) \
    __builtin_amdgcn_global_load_lds((const unsigned*)(src[i] + ((KT) << 6)), (unsigned*)(smem + (BUFI) * BUF + (tid + 256 * i) * 16), 16, 0, 0); }
  const int nk = K >> 6;
  const unsigned f = (unsigned)((c >> 1) & 7);
  const unsigned off0 = ((unsigned)g ^ f) * 16u, off1 = off0 ^ 64u;
  const unsigned rowA = (unsigned)(size_t)smem + (unsigned)((16 * MT * wm + c) * 128);
  const unsigned rowB = (unsigned)(size_t)smem + (unsigned)((RA + 16 * NT * wn + c) * 128);
  __syncthreads();
  DMA_ISSUE(0, 0);
  asm volatile("s_waitcnt vmcnt(0)" ::: "memory");
  __syncthreads();
  for (int kt = 0; kt < nk; ++kt) {
    const int cur = kt & 1;
    if (kt + 1 < nk) DMA_ISSUE(kt + 1, cur ^ 1);
    const unsigned bA = rowA + cur * BUF, bB = rowB + cur * BUF;
    bf16x8 xf[MT], wf[NT], xg[MT], wg[NT];
    lds_read_frags_sw(xf, wf, bA + off0, bB + off0);
    lds_issue_frags_sw(xg, wg, bA + off1, bB + off1);
#pragma unroll
    for (int mt = 0; mt < MT; ++mt)
#pragma unroll
      for (int nt = 0; nt < NT; ++nt) acc[mt][nt] = mfma16(wf[nt], xf[mt], acc[mt][nt]);
    lds_wait_frags(xg, wg, acc[MT - 1][0], acc[MT - 1][1], acc[MT - 1][NT - 2], acc[MT - 1][NT - 1]);
#pragma unroll
    for (int mt = 0; mt < MT; ++mt)
#pragma unroll
      for (int nt = 0; nt < NT; ++nt) acc[mt][nt] = mfma16(wg[nt], xg[mt], acc[mt][nt]);
    asm volatile("s_waitcnt vmcnt(0)" : "+v"(acc[0][0]), "+v"(acc[0][NT - 1]), "+v"(acc[MT - 1][0]), "+v"(acc[MT - 1][NT - 1]) :: "memory");
    __syncthreads();
  }
#undef DMA_ISSUE
}

DI void lds_issue_frags_sw(bf16x8 (&x)[5], bf16x8 (&w)[4], unsigned aA, unsigned aB) {
  asm volatile("ds_read_b128 %0, %9\n\tds_read_b128 %1, %9 offset:2048\n\tds_read_b128 %2, %9 offset:4096\n\tds_read_b128 %3, %9 offset:6144\n\tds_read_b128 %4, %9 offset:8192\n\t"
               "ds_read_b128 %5, %10\n\tds_read_b128 %6, %10 offset:2048\n\tds_read_b128 %7, %10 offset:4096\n\tds_read_b128 %8, %10 offset:6144"
               : "=&v"(x[0]), "=&v"(x[1]), "=&v"(x[2]), "=&v"(x[3]), "=&v"(x[4]), "=&v"(w[0]), "=&v"(w[1]), "=&v"(w[2]), "=&v"(w[3])
               : "v"(aA), "v"(aB) : "memory");
}
DI void lds_wait_frags_sw(bf16x8 (&x)[5], bf16x8 (&w)[4], f32x4& a0, f32x4& a1, f32x4& a2, f32x4& a3) {
  asm volatile("s_waitcnt lgkmcnt(0)"
               : "+v"(x[0]), "+v"(x[1]), "+v"(x[2]), "+v"(x[3]), "+v"(x[4]), "+v"(w[0]), "+v"(w[1]), "+v"(w[2]), "+v"(w[3]),
                 "+v"(a0), "+v"(a1), "+v"(a2), "+v"(a3) :: "memory");
}
DI void gemm_mainloop_dma_sw54p(const bf16_t* __restrict__ Ag, int lda, const bf16_t* __restrict__ Bg, int ldb, int K,
                                f32x4 (&acc)[5][4], char* smem) {
  constexpr int MT = 5, NT = 4, RA = 160, ROWS = 288, NI = 9, BUF = ROWS * 128;
  const int tid = get_tid(), lane = tid & 63, wave = __builtin_amdgcn_readfirstlane(tid >> 6), wm = wave >> 1, wn = wave & 1, c = lane & 15, g = lane >> 4;
  const bf16_t* src[NI];
#pragma unroll
  for (int i = 0; i < NI; ++i) {
    const int q = tid + 256 * i;
    const int row = q >> 3, x = (q & 7) ^ ((row >> 1) & 7);
    int rb = row - RA;
    { const int t = (rb >> 4) & 3, c4 = rb & 15; rb = (rb & ~63) + 32 * (t >> 1) + 8 * (c4 >> 2) + 4 * (t & 1) + (c4 & 3); }
    src[i] = (row < RA ? Ag + (size_t)row * lda : Bg + (size_t)rb * ldb) + x * 8;
  }
#define DMA_ISSUE(KT, BUFI) { _Pragma("unroll") for (int i = 0; i < NI; ++i) \
    __builtin_amdgcn_global_load_lds((const unsigned*)(src[i] + ((KT) << 6)), (unsigned*)(smem + (BUFI) * BUF + (tid + 256 * i) * 16), 16, 0, 0); }
  const int nk = K >> 6;
  const unsigned f = (unsigned)((c >> 1) & 7);
  const unsigned off0 = ((unsigned)g ^ f) * 16u, off1 = off0 ^ 64u;
  const unsigned rowA = (unsigned)(size_t)smem + (unsigned)((16 * MT * wm + c) * 128);
  const unsigned rowB = (unsigned)(size_t)smem + (unsigned)((RA + 16 * NT * wn + c) * 128);
  __syncthreads();
  DMA_ISSUE(0, 0);
  asm volatile("s_waitcnt vmcnt(0)" ::: "memory");
  __syncthreads();
  for (int kt = 0; kt < nk; ++kt) {
    const int cur = kt & 1;
    if (kt + 1 < nk) DMA_ISSUE(kt + 1, cur ^ 1);
    const unsigned bA = rowA + cur * BUF, bB = rowB + cur * BUF;
    bf16x8 xf[MT], wf[NT], xg[MT], wg[NT];
    lds_read_frags_sw(xf, wf, bA + off0, bB + off0);
    lds_issue_frags_sw(xg, wg, bA + off1, bB + off1);
#pragma unroll
    for (int mt = 0; mt < MT; ++mt)
#pragma unroll
      for (int nt = 0; nt < NT; ++nt) acc[mt][nt] = mfma16(wf[nt], xf[mt], acc[mt][nt]);
    lds_wait_frags_sw(xg, wg, acc[MT - 1][0], acc[MT - 1][1], acc[MT - 1][NT - 2], acc[MT - 1][NT - 1]);
#pragma unroll
    for (int mt = 0; mt < MT; ++mt)
#pragma unroll
      for (int nt = 0; nt < NT; ++nt) acc[mt][nt] = mfma16(wg[nt], xg[mt], acc[mt][nt]);
    asm volatile("s_waitcnt vmcnt(0)" : "+v"(acc[0][0]), "+v"(acc[0][NT - 1]), "+v"(acc[MT - 1][0]), "+v"(acc[MT - 1][NT - 1]) :: "memory");
    __syncthreads();
  }
#undef DMA_ISSUE
}

__device__ __forceinline__ void phase_inproj(const Params& p, int layer, char* smem) {
  const int tid = get_tid(), lane = tid & 63, wave = __builtin_amdgcn_readfirstlane(tid >> 6), wm = wave >> 1, wn = wave & 1, c = lane & 15, g = lane >> 4;
  const bf16_t* hm = (const bf16_t*)(p.ws + W_HMOD);
  const bf16_t* wt = (const bf16_t*)(p.ws + W_WTIN) + (size_t)layer * NPAD * 1024;
  bf16_t* parts = (bf16_t*)(p.ws + W_PARTS);
  const float2* rope = (const float2*)(p.ws + W_ROPE);
  const int ntiles = 64 * 67;
  for (int t = blockIdx.x; t < ntiles; t += gridDim.x) {
    const int m0 = (t % 64) * 160, n0 = (t / 64) * 128;
    f32x4 acc[5][4];
    zero_acc<5, 4>(acc);
    gemm_mainloop_dma_sw54p(hm + (size_t)m0 * 1024, 1024, wt + (size_t)n0 * 1024, 1024, 1024, acc, smem);
    const int nb = n0 + 64 * wn;
    const int mb = m0 + 80 * wm;
    if (nb >= 8448) {
      if (nb == 8448 && g < 2) {
        float* dt = (float*)(p.ws + W_DT);
#pragma unroll
        for (int mt = 0; mt < 5; ++mt) {
          const int tok = mb + 16 * mt + c;
          *(f32x4*)(dt + (size_t)tok * 16 + 8 * g) = acc[mt][0];
          *(f32x4*)(dt + (size_t)tok * 16 + 8 * g + 4) = acc[mt][1];
        }
      }
      continue;
    }
    const bool is_qa = nb < 512, is_ka = nb >= 512 && nb < 1024;
    const bool is_va = nb >= 1024 && nb < 1536, is_vc = nb >= 4352 && nb < 4864;
    const bool is_kc = nb >= 3840 && nb < 4352, is_qc = nb >= 3328 && nb < 3840;
    if (is_qa || is_ka) {
      const int fi = 8 * (g & 1);
      const float sgn = (g < 2) ? -1.f : 1.f;
#pragma unroll
      for (int mt = 0; mt < 5; ++mt) {
        if (mb + 16 * mt >= NCTX) {
          const int tl = (mb + 16 * mt + c - NCTX) & 1023;
          const int prow = tl >> 6, pcol = tl & 63;
#pragma unroll
          for (int nt = 0; nt < 4; ++nt) {
            const int pos = (nt >> 1) ? pcol : prow;
#pragma unroll
            for (int r = 0; r < 4; ++r) {
              const float2 cs = rope[pos * 16 + fi + 4 * (nt & 1) + r];
              const float own = acc[mt][nt][r];
              const float oth = __shfl_xor(own, 32);
              acc[mt][nt][r] = own * cs.x + sgn * oth * cs.y;
            }
          }
        }
      }
    }
    if (is_ka || is_va || is_kc || is_vc) {
      size_t obase; int cseg;
      if (is_ka) { obase = O_DK; cseg = nb - 512; }
      else if (is_va) { obase = O_DV; cseg = nb - 1024; }
      else if (is_kc) { obase = O_NK; cseg = nb - 3840; }
      else { obase = O_NV; cseg = nb - 4352; }
#pragma unroll
      for (int mt = 0; mt < 5; ++mt) {
        if (mb + 16 * mt < NCTX) {
          const int tok = mb + 16 * mt + c;
          const int b = tok >> 8, tt = tok & 255;
          float* o = p.out + obase + ((size_t)((b * 2 + layer) * 256 + tt)) * 512 + cseg + 8 * g;
#pragma unroll
          for (int q = 0; q < 2; ++q) { __builtin_nontemporal_store(acc[mt][2 * q], (f32x4*)(o + 32 * q)); __builtin_nontemporal_store(acc[mt][2 * q + 1], (f32x4*)(o + 32 * q + 4)); }
        }
      }
    }
    if (is_va || is_vc) {
      bf16_t* vt = (bf16_t*)(p.ws + (is_va ? W_VAT : W_VCT));
      const int cseg = is_va ? nb - 1024 : nb - 4352;
      constexpr int TS = 88;
      bf16_t* T = (bf16_t*)smem + wave * 64 * TS;
#pragma unroll
      for (int mt = 0; mt < 5; ++mt)
#pragma unroll
        for (int nt = 0; nt < 4; ++nt)
#pragma unroll
          for (int r = 0; r < 4; ++r) T[(32 * (nt >> 1) + 8 * g + 4 * (nt & 1) + r) * TS + 16 * mt + c] = f2bf(acc[mt][nt][r]);
#pragma unroll
      for (int j = 0; j < 10; ++j) {
        const int id = lane + 64 * j, rowc = id / 10, chk = id - rowc * 10;
        const u32x4 v = *(const u32x4*)(T + rowc * TS + chk * 8);
        *(u32x4*)(vt + (size_t)(cseg + rowc) * MTOK + mb + chk * 8) = v;
      }
    } else {
      const int pcol = nb < 1024 ? nb : (nb < 4352 ? nb - 512 : nb - 1024);
      const float sc = (is_qa || is_qc) ? 0.125f : 1.f;
#pragma unroll
      for (int mt = 0; mt < 5; ++mt) {
        const int tok = mb + 16 * mt + c;
        bf16_t* o = parts + (size_t)tok * LDP + pcol + 8 * g;
#pragma unroll
        for (int q = 0; q < 2; ++q) {
          u32x4 w;
          w.x = pack2(acc[mt][2 * q][0] * sc, acc[mt][2 * q][1] * sc); w.y = pack2(acc[mt][2 * q][2] * sc, acc[mt][2 * q][3] * sc);
          w.z = pack2(acc[mt][2 * q + 1][0] * sc, acc[mt][2 * q + 1][1] * sc); w.w = pack2(acc[mt][2 * q + 1][2] * sc, acc[mt][2 * q + 1][3] * sc);
          *(u32x4*)(o + 32 * q) = w;
        }
      }
    }
  }
}

struct AttnSeg { const bf16_t* k; int ldk; const bf16_t* v; int ldv; int ntiles; };

template <int NMAP, int DV, bool WIN>
DI void attn_core(const bf16_t* __restrict__ qrow, const AttnSeg s0, const AttnSeg s1, int qc, int dr0, const float* rpb_s,
                  bf16_t* Ks, bf16_t* Vts, f32x4 (&o)[NMAP][DV / 16], float (&lsum)[NMAP]) {
  const int tid = get_tid(), lane = tid & 63, wave = __builtin_amdgcn_readfirstlane(tid >> 6), c = lane & 15, g = lane >> 4;
  constexpr int NKC = NMAP * 2;
  constexpr int NVC = DV / 32;
  bf16x8 qf[NMAP][2];
#pragma unroll
  for (int m = 0; m < NMAP; ++m)
#pragma unroll
    for (int ks = 0; ks < 2; ++ks) qf[m][ks] = *(const bf16x8*)(qrow + m * 64 + 32 * ks + 8 * g);
  float mrun[NMAP];
#pragma unroll
  for (int m = 0; m < NMAP; ++m) {
    mrun[m] = -1e30f; lsum[m] = 0.f;
#pragma unroll
    for (int e = 0; e < DV / 16; ++e) o[m][e] = (f32x4){0.f, 0.f, 0.f, 0.f};
  }
  u32x4 rk[NKC], rv[NVC];
  const int ntot = s0.ntiles + s1.ntiles;
  auto gl = [&](int kt) {
    const bool first = kt < s0.ntiles;
    const int loc = first ? kt : kt - s0.ntiles;
    const bf16_t* kp = first ? s0.k : s1.k; const int ldk = first ? s0.ldk : s1.ldk;
    const bf16_t* vp = first ? s0.v : s1.v; const int ldv = first ? s0.ldv : s1.ldv;
    kp += (size_t)loc * 64 * ldk; vp += loc * 64;
#pragma unroll
    for (int i = 0; i < NKC; ++i) {
      int id = tid + 256 * i; int key = id / (NMAP * 8), cc = id % (NMAP * 8);
      rk[i] = *(const u32x4*)(kp + (size_t)key * ldk + cc * 8);
    }
#pragma unroll
    for (int i = 0; i < NVC; ++i) {
      int id = tid + 256 * i; int e = id >> 3, kc = (id & 7) * 8;
      rv[i] = *(const u32x4*)(vp + (size_t)e * ldv + kc);
    }
  };
  gl(0);
  for (int kt = 0; kt < ntot; ++kt) {
    __syncthreads();
#pragma unroll
    for (int i = 0; i < NKC; ++i) {
      int id = tid + 256 * i; int key = id / (NMAP * 8), cc = id % (NMAP * 8);
      *(u32x4*)(Ks + ((cc >> 3) * 64 + key) * LS + (cc & 7) * 8) = rk[i];
    }
#pragma unroll
    for (int i = 0; i < NVC; ++i) {
      int id = tid + 256 * i; int e = id >> 3, kc = (id & 7) * 8;
      *(u32x4*)(Vts + e * LS + kc) = rv[i];
    }
    __syncthreads();
    if (kt + 1 < ntot) gl(kt + 1);
    const bool win = WIN && kt >= s0.ntiles;
    const int nblk = win ? 1 : 2;
    for (int T = 0; T < nblk; ++T) {
      int kb = T * 32;
      if (win) kb = (wave == 0) ? 0 : (wave == 1 ? 8 : (wave == 2 ? 24 : 32));
      bf16x8 pf[NMAP];
      float alpha[NMAP];
#pragma unroll
      for (int m = 0; m < NMAP; ++m) {
        f32x4 sa = (f32x4){0.f, 0.f, 0.f, 0.f}, sb = sa;
        const int krow = kb + 8 * (c >> 2) + (c & 3);
#pragma unroll
        for (int ks = 0; ks < 2; ++ks) {
          bf16x8 a0 = lds_frag(Ks + m * 64 * LS, krow, 32 * ks + 8 * g);
          bf16x8 a1 = lds_frag(Ks + m * 64 * LS, krow + 4, 32 * ks + 8 * g);
          sa = mfma16(a0, qf[m][ks], sa);
          sb = mfma16(a1, qf[m][ks], sb);
        }
        if (win) {
          const int dr = dr0 + (kt - s0.ntiles);
          const int cs = min(max(qc - 8, 0), 48);
#pragma unroll
          for (int r = 0; r < 4; ++r) {
            int kc0 = kb + 8 * g + r, kc1 = kc0 + 4;
            int dc0 = min(max(kc0 - qc, -15), 15) + 15, dc1 = min(max(kc1 - qc, -15), 15) + 15;
            bool v0 = kc0 >= cs && kc0 < cs + 16, v1 = kc1 >= cs && kc1 < cs + 16;
            sa[r] = v0 ? sa[r] + rpb_s[dr * 31 + dc0] : -1e30f;
            sb[r] = v1 ? sb[r] + rpb_s[dr * 31 + dc1] : -1e30f;
          }
        }
        float mx = fmaxf(fmaxf(fmaxf(sa[0], sa[1]), fmaxf(sa[2], sa[3])), fmaxf(fmaxf(sb[0], sb[1]), fmaxf(sb[2], sb[3])));
        mx = fmaxf(mx, __shfl_xor(mx, 16));
        mx = fmaxf(mx, __shfl_xor(mx, 32));
        const float mnew = fmaxf(mrun[m], mx);
        alpha[m] = __expf(mrun[m] - mnew);
        mrun[m] = mnew;
        float ps = 0.f;
#pragma unroll
        for (int r = 0; r < 4; ++r) { sa[r] = __expf(sa[r] - mnew); sb[r] = __expf(sb[r] - mnew); ps += sa[r] + sb[r]; }
        lsum[m] = lsum[m] * alpha[m] + ps;
        union { u32x4 u; bf16x8 v; } cv;
        cv.u.x = pack2(sa[0], sa[1]); cv.u.y = pack2(sa[2], sa[3]); cv.u.z = pack2(sb[0], sb[1]); cv.u.w = pack2(sb[2], sb[3]);
        pf[m] = cv.v;
      }
#pragma unroll
      for (int e = 0; e < DV / 16; ++e) {
        bf16x8 vf = lds_frag(Vts, 16 * e + c, kb + 8 * g);
#pragma unroll
        for (int m = 0; m < NMAP; ++m) {
          f32x4 t = o[m][e] * alpha[m];
          o[m][e] = mfma16(vf, pf[m], t);
        }
      }
    }
  }
#pragma unroll
  for (int m = 0; m < NMAP; ++m) {
    float l = lsum[m];
    l += __shfl_xor(l, 16);
    l += __shfl_xor(l, 32);
    lsum[m] = l;
  }
}

__device__ __forceinline__ void item_diff_attn(const Params& p, int layer, bool lat, int b, int h, int qb, char* smem) {
  bf16_t* Ks = (bf16_t*)smem;
  bf16_t* Vts = Ks + 2 * 64 * LS;
  const int lane = get_tid() & 63, wave = __builtin_amdgcn_readfirstlane(get_tid() >> 6), c = lane & 15, g = lane >> 4;
  const bf16_t* parts = (const bf16_t*)(p.ws + W_PARTS);
  const bf16_t* vat = (const bf16_t*)(p.ws + W_VAT);
  const int row0 = lat ? NCTX + b * 1024 : b * 256;
  const int L = lat ? 1024 : 256;
  const int qrow_i = row0 + qb * 64 + 16 * wave + c;
  AttnSeg s0, s1;
  s0.k = parts + (size_t)row0 * LDP + PC_KA + h * 128; s0.ldk = LDP;
  s0.v = vat + (size_t)(h * 128) * MTOK + row0; s0.ldv = MTOK; s0.ntiles = L / 64;
  if (lat) {
    s1.k = (const bf16_t*)(p.ws + W_CKA) + (size_t)(b * 2 + layer) * 512 * 512 + h * 128; s1.ldk = 512;
    s1.v = (const bf16_t*)(p.ws + W_CVTA) + (size_t)(b * 2 + layer) * 512 * 512 + (size_t)(h * 128) * 512; s1.ldv = 512; s1.ntiles = 8;
  } else { s1 = s0; s1.ntiles = 0; }
  f32x4 o[2][8]; float ls[2];
  attn_core<2, 128, false>(parts + (size_t)qrow_i * LDP + PC_QA + h * 128, s0, s1, 0, 0, nullptr, Ks, Vts, o, ls);
  const float lam = ((const float*)(p.ws + W_LAM))[layer];
  const float li = lam_init_of(layer);
  const float i0 = 1.f / ls[0], i1 = lam / ls[1];
  float ss = 0.f;
#pragma unroll
  for (int e = 0; e < 8; ++e)
#pragma unroll
    for (int r = 0; r < 4; ++r) { float v = o[0][e][r] * i0 - o[1][e][r] * i1; o[0][e][r] = v; ss += v * v; }
  ss += __shfl_xor(ss, 16);
  ss += __shfl_xor(ss, 32);
  const float rstd = rsqrtf(ss * (1.f / 128.f) + EPS) * (1.f - li);
  const float* sg = p.subln_g + layer * 128;
  const bf16_t* ga = parts + (size_t)qrow_i * LDP + PC_GA + h * 128;
  bf16_t* ya = (bf16_t*)(p.ws + W_PARTS) + (size_t)qrow_i * LDP + PC_QA + h * 128;
#pragma unroll
  for (int e = 0; e < 8; ++e) {
    int ec = 16 * e + 4 * g;
    u32x2 gv = *(const u32x2*)(ga + ec);
    f32x4 sgv = *(const f32x4*)(sg + ec);
    float v0 = o[0][e][0] * rstd * sgv[0] * siluf(bflo(gv.x));
    float v1 = o[0][e][1] * rstd * sgv[1] * siluf(bfhi(gv.x));
    float v2 = o[0][e][2] * rstd * sgv[2] * siluf(bflo(gv.y));
    float v3 = o[0][e][3] * rstd * sgv[3] * siluf(bfhi(gv.y));
    u32x2 w; w.x = pack2(v0, v1); w.y = pack2(v2, v3);
    *(u32x2*)(ya + ec) = w;
  }
}

__device__ __forceinline__ void item_c_attn(const Params& p, int layer, bool lat, int b, int h, int qb, char* smem) {
  bf16_t* Ks = (bf16_t*)smem;
  bf16_t* Vts = Ks + 2 * 64 * LS;
  float* rpb_s = (float*)(Vts + 128 * LS);
  const int lane = get_tid() & 63, wave = __builtin_amdgcn_readfirstlane(get_tid() >> 6), c = lane & 15, g = lane >> 4;
  const bf16_t* parts = (const bf16_t*)(p.ws + W_PARTS);
  const bf16_t* vct = (const bf16_t*)(p.ws + W_VCT);
  f32x4 o[1][4]; float ls[1];
  int qrow_i;
  if (!lat) {
    const int row0 = b * 256;
    qrow_i = row0 + qb * 64 + 16 * wave + c;
    AttnSeg s0, s1;
    s0.k = parts + (size_t)row0 * LDP + PC_KC + h * 64; s0.ldk = LDP;
    s0.v = vct + (size_t)(h * 64) * MTOK + row0; s0.ldv = MTOK; s0.ntiles = 4;
    s1 = s0; s1.ntiles = 0;
    attn_core<1, 64, false>(parts + (size_t)qrow_i * LDP + PC_QC + h * 64, s0, s1, 0, 0, nullptr, Ks, Vts, o, ls);
  } else {
    const int row0 = NCTX + b * 1024;
    const int r = qb;
    qrow_i = row0 + r * 64 + 16 * wave + c;
    const int r0 = min(max(r - 4, 0), 8);
    __syncthreads();
    for (int i = get_tid(); i < 465; i += 256) rpb_s[i] = p.na_rpb[((size_t)layer * 8 + h) * 465 + i];
    __syncthreads();
    AttnSeg s0, s1;
    s0.k = (const bf16_t*)(p.ws + W_CKC) + (size_t)(b * 2 + layer) * 512 * 512 + h * 64; s0.ldk = 512;
    s0.v = (const bf16_t*)(p.ws + W_CVTC) + (size_t)(b * 2 + layer) * 512 * 512 + (size_t)(h * 64) * 512; s0.ldv = 512; s0.ntiles = 8;
    s1.k = parts + (size_t)(row0 + r0 * 64) * LDP + PC_KC + h * 64; s1.ldk = LDP;
    s1.v = vct + (size_t)(h * 64) * MTOK + row0 + r0 * 64; s1.ldv = MTOK; s1.ntiles = 8;
    attn_core<1, 64, true>(parts + (size_t)qrow_i * LDP + PC_QC + h * 64, s0, s1, 16 * wave + c, r0 - r + 7, rpb_s, Ks, Vts, o, ls);
  }
  const float inv = 1.f / ls[0];
  const bf16_t* gc = parts + (size_t)qrow_i * LDP + PC_GC + h * 64;
  bf16_t* yc = (bf16_t*)(p.ws + W_PARTS) + (size_t)qrow_i * LDP + PC_QC + h * 64;
#pragma unroll
  for (int e = 0; e < 4; ++e) {
    int ec = 16 * e + 4 * g;
    u32x2 gv = *(const u32x2*)(gc + ec);
    float v0 = o[0][e][0] * inv * siluf(bflo(gv.x));
    float v1 = o[0][e][1] * inv * siluf(bfhi(gv.x));
    float v2 = o[0][e][2] * inv * siluf(bflo(gv.y));
    float v3 = o[0][e][3] * inv * siluf(bfhi(gv.y));
    u32x2 w; w.x = pack2(v0, v1); w.y = pack2(v2, v3);
    *(u32x2*)(yc + ec) = w;
  }
}

DI int ssd_slot(bool lat, int b, int h, int d, int cd) { return lat ? 2048 + ((b * 8 + h) * 2 + d) * 16 + cd : ((b * 8 + h) * 2 + d) * 4 + cd; }

__device__ __forceinline__ void item_ssd1(const Params& p, int layer, bool lat, int b, int gq, int ch, char* smem) {
  bf16_t* Cs = (bf16_t*)smem;
  bf16_t* Bs = Cs + 64 * LS;
  bf16_t* BsT = Bs + 64 * LS;
  bf16_t* XsT = BsT + 64 * LS;
  float* acum = (float*)(XsT + 4 * 64 * LS);
  float* dts = acum + 512;
  const int tid = get_tid(), lane = tid & 63, wave = __builtin_amdgcn_readfirstlane(tid >> 6), c = lane & 15, g = lane >> 4;
  const int row0 = lat ? NCTX + b * 1024 : b * 256;
  const int L = lat ? 1024 : 256;
  const int nch = L / 64;
  const int tbase = row0 + 64 * ch;
  const bf16_t* parts = (const bf16_t*)(p.ws + W_PARTS);
  const float* dtg = (const float*)(p.ws + W_DT);
  float* eag = (float*)(p.ws + W_EA);
  bf16_t* ccg = (bf16_t*)(p.ws + W_CC);
  bf16_t* scg = (bf16_t*)(p.ws + W_HMOD);
  __syncthreads();
#pragma unroll
  for (int q = 0; q < 2; ++q) {
    const int hd = wave + 4 * q, d = hd >> 2, h = gq * 4 + (hd & 3);
    float raw = dtg[(size_t)(tbase + lane) * 16 + d * 8 + h] + p.dt_bias[(layer * 2 + d) * 8 + h];
    float dt = raw > 20.f ? raw : log1pf(expf(raw));
    float la = dt * (-expf(p.a_log[(layer * 2 + d) * 8 + h]));
    if (d == 0) {
#pragma unroll
      for (int off = 1; off < 64; off <<= 1) { float t = __shfl_up(la, off); if (lane >= off) la += t; }
    } else {
#pragma unroll
      for (int off = 1; off < 64; off <<= 1) { float t = __shfl_down(la, off); if (lane + off < 64) la += t; }
    }
    acum[hd * 64 + lane] = la; dts[hd * 64 + lane] = dt;
    eag[(size_t)(tbase + lane) * 16 + d * 8 + h] = __expf(la);
  }
#pragma unroll
  for (int grp = 0; grp < 3; ++grp) {
    u32x4 rv[4][5];
#pragma unroll
    for (int u = 0; u < 4; ++u) {
      const int it = grp * 4 + u;
      const int vi = tid + 256 * it;
      int i, chn;
      if (it < 8) { i = vi >> 5; chn = gq * 256 + (vi & 31) * 8; }
      else if (it < 10) { int rem = vi - 2048; i = rem >> 3; chn = 512 + gq * 64 + (rem & 7) * 8; }
      else { int rem = vi - 2560; i = rem >> 3; chn = 640 + gq * 64 + (rem & 7) * 8; }
      const int tok = 64 * ch + i;
#pragma unroll
      for (int k = 0; k < 5; ++k) {
        const int tt = tok + k - 2;
        rv[u][k] = (u32x4){0u, 0u, 0u, 0u};
        if (tt >= 0 && tt < L) rv[u][k] = *(const u32x4*)(parts + (size_t)(row0 + tt) * LDP + PC_XBC + chn);
      }
    }
#pragma unroll
    for (int u = 0; u < 4; ++u) {
      const int it = grp * 4 + u;
      const int vi = tid + 256 * it;
      int i, cc, chn;
      if (it < 8) { i = vi >> 5; cc = (vi & 31) * 8; chn = gq * 256 + cc; }
      else if (it < 10) { int rem = vi - 2048; i = rem >> 3; cc = (rem & 7) * 8; chn = 512 + gq * 64 + cc; }
      else { int rem = vi - 2560; i = rem >> 3; cc = (rem & 7) * 8; chn = 640 + gq * 64 + cc; }
      float a8[8];
      {
        const float* cb = p.conv_b + layer * 768 + chn;
        f32x4 b0 = *(const f32x4*)cb, b1 = *(const f32x4*)(cb + 4);
        a8[0] = b0[0]; a8[1] = b0[1]; a8[2] = b0[2]; a8[3] = b0[3]; a8[4] = b1[0]; a8[5] = b1[1]; a8[6] = b1[2]; a8[7] = b1[3];
      }
#pragma unroll
      for (int k = 0; k < 5; ++k) {
        float f[8]; unpack8(rv[u][k], f);
        const float* cw = p.conv_w + (size_t)(layer * 5 + k) * 768 + chn;
        f32x4 w0 = *(const f32x4*)cw, w1 = *(const f32x4*)(cw + 4);
        a8[0] += w0[0] * f[0]; a8[1] += w0[1] * f[1]; a8[2] += w0[2] * f[2]; a8[3] += w0[3] * f[3];
        a8[4] += w1[0] * f[4]; a8[5] += w1[1] * f[5]; a8[6] += w1[2] * f[6]; a8[7] += w1[3] * f[7];
      }
#pragma unroll
      for (int j = 0; j < 8; ++j) a8[j] = siluf(a8[j]);
      if (it < 8) {
        bf16_t* xd = XsT + (cc >> 6) * 64 * LS + (cc & 63) * LS + i;
#pragma unroll
        for (int j = 0; j < 8; ++j) xd[j * LS] = f2bf(a8[j]);
      } else {
        u32x4 w; w.x = pack2(a8[0], a8[1]); w.y = pack2(a8[2], a8[3]); w.z = pack2(a8[4], a8[5]); w.w = pack2(a8[6], a8[7]);
        if (it < 10) {
          *(u32x4*)(Bs + i * LS + cc) = w;
#pragma unroll
          for (int j = 0; j < 8; ++j) BsT[(cc + j) * LS + i] = f2bf(a8[j]);
        } else {
          *(u32x4*)(Cs + i * LS + cc) = w;
          *(u32x4*)(ccg + (size_t)(tbase + i) * 128 + gq * 64 + cc) = w;
        }
      }
    }
  }
  __syncthreads();
  const int il = 16 * wave + c;
  bf16x8 cf[2];
  cf[0] = lds_frag(Cs, il, 8 * g); cf[1] = lds_frag(Cs, il, 32 + 8 * g);
  f32x4 ga[2], gb[2];
#pragma unroll
  for (int T = 0; T < 2; ++T) {
    ga[T] = (f32x4){0.f, 0.f, 0.f, 0.f}; gb[T] = ga[T];
    const int jrow = 32 * T + 8 * (c >> 2) + (c & 3);
#pragma unroll
    for (int ks = 0; ks < 2; ++ks) {
      ga[T] = mfma16(lds_frag(Bs, jrow, 32 * ks + 8 * g), cf[ks], ga[T]);
      gb[T] = mfma16(lds_frag(Bs, jrow + 4, 32 * ks + 8 * g), cf[ks], gb[T]);
    }
  }
  float btf[2][8];
#pragma unroll
  for (int ks = 0; ks < 2; ++ks) {
    u32x4 v = *(const u32x4*)(BsT + (16 * wave + c) * LS + 32 * ks + 8 * g);
    unpack8(v, btf[ks]);
  }
#pragma unroll 1
  for (int hd = 0; hd < 8; ++hd) {
    const int d = hd >> 2, hp = hd & 3, h = gq * 4 + hp;
    const float* ac = acum + hd * 64;
    const float* dtv = dts + hd * 64;
    const bf16_t* Xh = XsT + hp * 64 * LS;
    const float ai = ac[il];
    f32x4 yacc[4];
#pragma unroll
    for (int pt = 0; pt < 4; ++pt) yacc[pt] = (f32x4){0.f, 0.f, 0.f, 0.f};
#pragma unroll
    for (int T = 0; T < 2; ++T) {
      const bool skipT = (d == 0) ? (T == 1 && wave < 2) : (T == 0 && wave >= 2);
      if (!skipT) {
        float pa[4], pb[4];
#pragma unroll
        for (int r = 0; r < 4; ++r) {
          const int j0 = 32 * T + 8 * g + r, j1 = j0 + 4;
          const bool ok0 = (d == 0) ? (j0 <= il) : (j0 >= il);
          const bool ok1 = (d == 0) ? (j1 <= il) : (j1 >= il);
          const float f0 = ok0 ? __expf(fminf(ai - ac[j0], 0.f)) * dtv[j0] : 0.f;
          const float f1 = ok1 ? __expf(fminf(ai - ac[j1], 0.f)) * dtv[j1] : 0.f;
          pa[r] = ga[T][r] * f0; pb[r] = gb[T][r] * f1;
        }
        union { u32x4 u; bf16x8 v; } cv;
        cv.u.x = pack2(pa[0], pa[1]); cv.u.y = pack2(pa[2], pa[3]); cv.u.z = pack2(pb[0], pb[1]); cv.u.w = pack2(pb[2], pb[3]);
#pragma unroll
        for (int pt = 0; pt < 4; ++pt) yacc[pt] = mfma16(lds_frag(Xh, 16 * pt + c, 32 * T + 8 * g), cv.v, yacc[pt]);
      }
    }
    if (d == 0) {
      const float dsk = p.d_skip[(layer * 2 + 0) * 8 + h] + p.d_skip[(layer * 2 + 1) * 8 + h];
#pragma unroll
      for (int pt = 0; pt < 4; ++pt)
#pragma unroll
        for (int r = 0; r < 4; ++r) yacc[pt][r] += dsk * bf2f(Xh[(16 * pt + 4 * g + r) * LS + il]);
    }
    {
      bf16_t* yo = (bf16_t*)(p.ws + (d == 0 ? W_YBF : W_YBB)) + (size_t)(tbase + il) * 512 + h * 64 + 4 * g;
#pragma unroll
      for (int pt = 0; pt < 4; ++pt) {
        u32x2 w; w.x = pack2(yacc[pt][0], yacc[pt][1]); w.y = pack2(yacc[pt][2], yacc[pt][3]);
        *(u32x2*)(yo + 16 * pt) = w;
      }
    }
    {
      const float aend = (d == 0) ? ac[63] : ac[0];
      bf16x8 aw[2];
#pragma unroll
      for (int ks = 0; ks < 2; ++ks) {
        float s8[8];
#pragma unroll
        for (int e = 0; e < 8; ++e) { const int j = 32 * ks + 8 * g + e; s8[e] = btf[ks][e] * dtv[j] * __expf(aend - ac[j]); }
        union { u32x4 u; bf16x8 v; } cv;
        cv.u.x = pack2(s8[0], s8[1]); cv.u.y = pack2(s8[2], s8[3]); cv.u.z = pack2(s8[4], s8[5]); cv.u.w = pack2(s8[6], s8[7]);
        aw[ks] = cv.v;
      }
      const int cd = (d == 0) ? ch : nch - 1 - ch;
      bf16_t* so = scg + (size_t)ssd_slot(lat, b, h, d, cd) * 4096 + 16 * wave + 4 * g;
#pragma unroll
      for (int pt = 0; pt < 4; ++pt) {
        f32x4 t = (f32x4){0.f, 0.f, 0.f, 0.f};
#pragma unroll
        for (int ks = 0; ks < 2; ++ks) t = mfma16(aw[ks], lds_frag(Xh, 16 * pt + c, 32 * ks + 8 * g), t);
        u32x2 w; w.x = pack2(t[0], t[1]); w.y = pack2(t[2], t[3]);
        *(u32x2*)(so + (16 * pt + c) * 64) = w;
      }
    }
  }
}

template <int NCH>
DI void ssd_scan_chain(const Params& p, int layer, bool lat, int b, int h, int d, int half) {
  const int tid = get_tid();
  const int e = half * 2048 + tid * 8;
  const int row0 = lat ? NCTX + b * 1024 : b * 256;
  bf16_t* sc = (bf16_t*)(p.ws + W_HMOD) + (size_t)ssd_slot(lat, b, h, d, 0) * 4096 + e;
  const float* eag = (const float*)(p.ws + W_EA);
  float hr[8];
  if (lat) {
    const float* h0 = p.state_ssd + ((size_t)((b * 2 + layer) * 2 + d) * 8 + h) * 4096 + e;
    f32x4 a = *(const f32x4*)h0, bq = *(const f32x4*)(h0 + 4);
    hr[0] = a[0]; hr[1] = a[1]; hr[2] = a[2]; hr[3] = a[3]; hr[4] = bq[0]; hr[5] = bq[1]; hr[6] = bq[2]; hr[7] = bq[3];
  } else {
#pragma unroll
    for (int j = 0; j < 8; ++j) hr[j] = 0.f;
  }
  u32x4 tmp[NCH];
  float dec[NCH];
#pragma unroll
  for (int cd = 0; cd < NCH; ++cd) {
    tmp[cd] = *(const u32x4*)(sc + (size_t)cd * 4096);
    const int cf = d ? NCH - 1 - cd : cd;
    dec[cd] = eag[(size_t)(row0 + 64 * cf + (d ? 0 : 63)) * 16 + d * 8 + h];
  }
#pragma unroll
  for (int cd = 0; cd < NCH; ++cd) {
    u32x4 w; w.x = pack2(hr[0], hr[1]); w.y = pack2(hr[2], hr[3]); w.z = pack2(hr[4], hr[5]); w.w = pack2(hr[6], hr[7]);
    *(u32x4*)(sc + (size_t)cd * 4096) = w;
    float f[8]; unpack8(tmp[cd], f);
#pragma unroll
    for (int j = 0; j < 8; ++j) hr[j] = dec[cd] * hr[j] + f[j];
  }
  if (!lat) {
    float* ho = p.out + O_SS + ((size_t)((b * 2 + layer) * 2 + d) * 8 + h) * 4096 + e;
    *(f32x4*)ho = (f32x4){hr[0], hr[1], hr[2], hr[3]};
    *(f32x4*)(ho + 4) = (f32x4){hr[4], hr[5], hr[6], hr[7]};
  }
}

__device__ __forceinline__ void phase_ssd_scan(const Params& p, int layer) {
  for (int i = blockIdx.x * 256 + get_tid(); i < MTOK; i += gridDim.x * 256) ((float*)(p.ws + W_RSTD))[i] = 0.f;
  for (int it = blockIdx.x; it < 1088; it += gridDim.x) {
    const int chain = it >> 1, half = it & 1;
    if (chain < 512) ssd_scan_chain<4>(p, layer, false, chain >> 4, (chain >> 1) & 7, chain & 1, half);
    else { const int cl = chain - 512; ssd_scan_chain<16>(p, layer, true, cl >> 4, (cl >> 1) & 7, cl & 1, half); }
  }
}

__device__ __forceinline__ void phase_ssd_final(const Params& p, int layer, char* smem) {
  bf16_t* Cs2 = (bf16_t*)smem;
  bf16_t* Hs = Cs2 + 2 * 64 * LS;
  float* eas = (float*)(Hs + 2 * 64 * LS);
  const int tid = get_tid(), lane = tid & 63, wave = __builtin_amdgcn_readfirstlane(tid >> 6), c = lane & 15, g = lane >> 4;
  const bf16_t* parts = (const bf16_t*)(p.ws + W_PARTS);
  const bf16_t* scg = (const bf16_t*)(p.ws + W_HMOD);
  const bf16_t* ccg = (const bf16_t*)(p.ws + W_CC);
  const float* eag = (const float*)(p.ws + W_EA);
  bf16_t* yf = (bf16_t*)(p.ws + W_YBF);
  const bf16_t* ybk = (const bf16_t*)(p.ws + W_YBB);
  const float* ng = p.ssd_norm_g + layer * 512;
  for (int it2 = blockIdx.x; it2 < 320; it2 += gridDim.x) {
    const int it = it2 >> 1, hh = it2 & 1;
    const bool lat = it >= 128;
    const int b = lat ? (it - 128) >> 4 : it >> 2;
    const int ch = lat ? (it - 128) & 15 : it & 3;
    const int nch = lat ? 16 : 4;
    const int tbase = (lat ? NCTX + b * 1024 : b * 256) + 64 * ch;
    __syncthreads();
#pragma unroll
    for (int i4 = 0; i4 < 4; ++i4) {
      int vi = tid + 256 * i4; int i = vi >> 4, cc = (vi & 15) * 8;
      u32x4 v = *(const u32x4*)(ccg + (size_t)(tbase + i) * 128 + cc);
      *(u32x4*)(Cs2 + (cc >> 6) * 64 * LS + i * LS + (cc & 63)) = v;
    }
    *(f32x4*)(eas + tid * 4) = *(const f32x4*)(eag + (size_t)tbase * 16 + tid * 4);
    const int il = 16 * wave + c;
    const size_t row = (size_t)(tbase + il);
    u32x4 hreg[2];
    {
      const bf16_t* s = scg + (size_t)ssd_slot(lat, b, 4 * hh, 0, ch) * 4096;
      hreg[0] = *(const u32x4*)(s + tid * 8); hreg[1] = *(const u32x4*)(s + 2048 + tid * 8);
    }
    float ss = 0.f;
#pragma unroll 1
    for (int h = 4 * hh; h < 4 * hh + 4; ++h) {
      f32x4 y[4];
#pragma unroll
      for (int pt = 0; pt < 4; ++pt) y[pt] = (f32x4){0.f, 0.f, 0.f, 0.f};
#pragma unroll
      for (int d = 0; d < 2; ++d) {
        bf16_t* Hb = Hs + d * 64 * LS;
        {
          int e0 = tid * 8;
          *(u32x4*)(Hb + (e0 >> 6) * LS + (e0 & 63)) = hreg[0];
          *(u32x4*)(Hb + ((e0 + 2048) >> 6) * LS + (e0 & 63)) = hreg[1];
        }
        __syncthreads();
        {
          const int k1 = 2 * h + d + 1;
          if (k1 < 8 * hh + 8) {
            const int h2 = k1 >> 1, d2 = k1 & 1;
            const bf16_t* s = scg + (size_t)ssd_slot(lat, b, h2, d2, d2 ? nch - 1 - ch : ch) * 4096;
            hreg[0] = *(const u32x4*)(s + tid * 8); hreg[1] = *(const u32x4*)(s + 2048 + tid * 8);
          }
        }
        const bf16_t* Cq = Cs2 + (h >> 2) * 64 * LS;
        const bf16x8 c0 = lds_frag(Cq, il, 8 * g), c1 = lds_frag(Cq, il, 32 + 8 * g);
        const float ea = eas[il * 16 + d * 8 + h];
#pragma unroll
        for (int pt = 0; pt < 4; ++pt) {
          f32x4 t = (f32x4){0.f, 0.f, 0.f, 0.f};
          t = mfma16(lds_frag(Hb, 16 * pt + c, 8 * g), c0, t);
          t = mfma16(lds_frag(Hb, 16 * pt + c, 32 + 8 * g), c1, t);
          y[pt] += t * ea;
        }
      }
#pragma unroll
      for (int pt = 0; pt < 4; ++pt) {
        const int col = h * 64 + 16 * pt + 4 * g;
        u32x2 a = *(const u32x2*)(yf + row * 512 + col);
        u32x2 bq = *(const u32x2*)(ybk + row * 512 + col);
        u32x2 z = *(const u32x2*)(parts + row * LDP + PC_Z + col);
        f32x4 gv = *(const f32x4*)(ng + col);
        float y0 = (y[pt][0] + bflo(a.x) + bflo(bq.x)) * siluf(bflo(z.x));
        float y1 = (y[pt][1] + bfhi(a.x) + bfhi(bq.x)) * siluf(bfhi(z.x));
        float y2 = (y[pt][2] + bflo(a.y) + bflo(bq.y)) * siluf(bflo(z.y));
        float y3 = (y[pt][3] + bfhi(a.y) + bfhi(bq.y)) * siluf(bfhi(z.y));
        ss += y0 * y0 + y1 * y1 + y2 * y2 + y3 * y3;
        u32x2 w; w.x = pack2(y0 * gv[0], y1 * gv[1]); w.y = pack2(y2 * gv[2], y3 * gv[3]);
        *(u32x2*)(yf + row * 512 + col) = w;
      }
    }
    ss += __shfl_xor(ss, 16);
    ss += __shfl_xor(ss, 32);
    if (g == 0) atomicAdd((float*)(p.ws + W_RSTD) + row, ss);
  }
}

__device__ __forceinline__ void phase_mixers(const Params& p, int layer, char* smem) {
  constexpr int N0 = 128, N1 = N0 + 256, N2 = N1 + 64, N3 = N2 + 256, N4 = N3 + 512, N5 = N4 + 1024;
  __shared__ int s_item;
  unsigned* ctr = (unsigned*)(p.ws + W_BAR) + 3584 + 64 * layer;
  for (;;) {
    __syncthreads();
    if (threadIdx.x == 0) s_item = (int)atomicAdd(ctr, 1u);
    __syncthreads();
    const int it = __builtin_amdgcn_readfirstlane(s_item);
    if (it >= N5) break;
    if (it < N0) { int j = it; item_diff_attn(p, layer, true, j >> 6, (j >> 4) & 3, j & 15, smem); }
    else if (it < N1) { int j = it - N0; item_c_attn(p, layer, true, j >> 7, (j >> 4) & 7, j & 15, smem); }
    else if (it < N2) { int j = it - N1; item_ssd1(p, layer, true, j >> 5, (j >> 4) & 1, j & 15, smem); }
    else if (it < N3) { int j = it - N2; item_ssd1(p, layer, false, j >> 3, (j >> 2) & 1, j & 3, smem); }
    else if (it < N4) { int j = it - N3; item_diff_attn(p, layer, false, j >> 4, (j >> 2) & 3, j & 3, smem); }
    else { int j = it - N4; item_c_attn(p, layer, false, j >> 5, (j >> 2) & 7, j & 3, smem); }
  }
}

__device__ __forceinline__ void phase_branch(const Params& p, int layer, char* smem) {
  const int tid = get_tid(), lane = tid & 63, wave = __builtin_amdgcn_readfirstlane(tid >> 6), wm = wave >> 1, wn = wave & 1, c = lane & 15, g = lane >> 4;
  const bf16_t* parts = (const bf16_t*)(p.ws + W_PARTS);
  const int ntiles = 64 * 8;
  for (int t = blockIdx.x; t < ntiles; t += gridDim.x) {
    const int m0 = (t % 64) * 160, n0 = (t / 64) * 128;
    const int mb = m0 + 80 * wm, nb = n0 + 64 * wn;
    f32x4 tot[5][4];
    zero_acc<5, 4>(tot);
#pragma unroll 1
    for (int br = 0; br < 3; ++br) {
      const bf16_t* A = (br == 0) ? parts + PC_QA : (br == 1 ? (const bf16_t*)(p.ws + W_YBF) : parts + PC_QC);
      const int lda = (br == 1) ? 512 : LDP;
      const bf16_t* Bt = (const bf16_t*)(p.ws + W_WTBR) + (size_t)(layer * 3 + br) * 1024 * 512;
      f32x4 acc[5][4];
      zero_acc<5, 4>(acc);
      gemm_mainloop_dma_sw<true, 4>(A + (size_t)m0 * lda, lda, Bt + (size_t)n0 * 512, 512, 512, acc, smem);
      int lane_e = lane; asm volatile("" : "+v"(lane_e));
      const int ce = lane_e & 15, ge = lane_e >> 4;
#pragma unroll
      for (int mt = 0; mt < 5; ++mt) {
        const int tok = mb + 16 * mt + ce;
        const float rs = (br == 1) ? rsqrtf(((const float*)(p.ws + W_RSTD))[tok] * (1.f / 512.f) + EPS) : 1.f;
#pragma unroll
        for (int q = 0; q < 2; ++q) {
          const u32x4 v = *(const u32x4*)(parts + (size_t)tok * LDP + PC_MG + br * 1024 + nb + 32 * q + 8 * ge);
          tot[mt][2 * q][0] += sigmf(bflo(v.x)) * rs * acc[mt][2 * q][0];
          tot[mt][2 * q][1] += sigmf(bfhi(v.x)) * rs * acc[mt][2 * q][1];
          tot[mt][2 * q][2] += sigmf(bflo(v.y)) * rs * acc[mt][2 * q][2];
          tot[mt][2 * q][3] += sigmf(bfhi(v.y)) * rs * acc[mt][2 * q][3];
          tot[mt][2 * q + 1][0] += sigmf(bflo(v.z)) * rs * acc[mt][2 * q + 1][0];
          tot[mt][2 * q + 1][1] += sigmf(bfhi(v.z)) * rs * acc[mt][2 * q + 1][1];
          tot[mt][2 * q + 1][2] += sigmf(bflo(v.w)) * rs * acc[mt][2 * q + 1][2];
          tot[mt][2 * q + 1][3] += sigmf(bfhi(v.w)) * rs * acc[mt][2 * q + 1][3];
        }
      }
    }
#pragma unroll
    for (int mt = 0; mt < 5; ++mt) {
      const int tok = mb + 16 * mt + c;
#pragma unroll
      for (int q = 0; q < 2; ++q) {
        u32x4 w;
        w.x = pack2(tot[mt][2 * q][0], tot[mt][2 * q][1]); w.y = pack2(tot[mt][2 * q][2], tot[mt][2 * q][3]);
        w.z = pack2(tot[mt][2 * q + 1][0], tot[mt][2 * q + 1][1]); w.w = pack2(tot[mt][2 * q + 1][2], tot[mt][2 * q + 1][3]);
        *(u32x4*)((bf16_t*)(p.ws + W_HMOD) + (size_t)tok * 1024 + nb + 32 * q + 8 * g) = w;
      }
    }
  }
}

__device__ __forceinline__ void phase_outproj(const Params& p, int layer, char* smem) {
  const int tid = get_tid(), lane = tid & 63, wave = __builtin_amdgcn_readfirstlane(tid >> 6), wm = wave >> 1, wn = wave & 1, c = lane & 15, g = lane >> 4;
  const bf16_t* wt = (const bf16_t*)(p.ws + W_WTOUT) + (size_t)layer * 1024 * 1024;
  const int ntiles = 64 * 8;
  for (int t = blockIdx.x; t < ntiles; t += gridDim.x) {
    const int m0 = (t % 64) * 160, n0 = (t / 64) * 128;
    const int mb = m0 + 80 * wm, nb = n0 + 64 * wn;
    f32x4 acc[5][4];
    zero_acc<5, 4>(acc);
    gemm_mainloop_dma_sw<true>((const bf16_t*)(p.ws + W_HMOD) + (size_t)m0 * 1024, 1024, wt + (size_t)n0 * 1024, 1024, 1024, acc, smem);
#pragma unroll
    for (int mt = 0; mt < 5; ++mt) {
      const int tok = mb + 16 * mt + c;
      const float* xin = (layer == 0) ? (tok < NCTX ? p.x_prompt + (size_t)tok * 1024 : p.x_sample + (size_t)(tok - NCTX) * 1024)
                                      : p.out + (size_t)tok * 1024;
      const int v = tok < NCTX ? 0 : 1 + ((tok - NCTX) >> 10);
      const float* gate = (const float*)(p.ws + W_ADA) + (layer * 3 + v) * 3072 + 2048;
      float* xo = p.out + (size_t)tok * 1024;
#pragma unroll
      for (int nt = 0; nt < 4; ++nt) {
        const int col = nb + 32 * (nt >> 1) + 8 * g + 4 * (nt & 1);
        f32x4 xv = *(const f32x4*)(xin + col);
        f32x4 gv = *(const f32x4*)(gate + col);
        *(f32x4*)(xo + col) = xv + gv * acc[mt][nt];
      }
    }
  }
}

__device__ __forceinline__ void phase_final(const Params& p) {
  const int lane = get_tid() & 63, wave = __builtin_amdgcn_readfirstlane(get_tid() >> 6);
  const int gw = blockIdx.x * 4 + wave, nw = gridDim.x * 4;
  for (int row = gw; row < MTOK; row += nw) {
    float* x = p.out + (size_t)row * 1024;
    float4 xv[4];
    float ss = 0.f;
#pragma unroll
    for (int i = 0; i < 4; ++i) {
      xv[i] = *(const float4*)(x + (i * 64 + lane) * 4);
      ss += xv[i].x * xv[i].x + xv[i].y * xv[i].y + xv[i].z * xv[i].z + xv[i].w * xv[i].w;
    }
    ss = wave_sum(ss);
    const float rstd = rsqrtf(ss * (1.f / 1024.f) + EPS);
#pragma unroll
    for (int i = 0; i < 4; ++i) {
      int col = (i * 64 + lane) * 4;
      float4 g = *(const float4*)(p.final_g + col);
      float4 r;
      r.x = xv[i].x * rstd * g.x; r.y = xv[i].y * rstd * g.y; r.z = xv[i].z * rstd * g.z; r.w = xv[i].w * rstd * g.w;
      *(float4*)(x + col) = r;
    }
  }
}

#define XB_TMO      128
#define XB_XCNT(j)  (256  + 64 * (j))
#define XB_XSUB(j)  (1280 + 64 * (j))
#define XB_XGEN(j)  (2304 + 64 * (j))
#define XB_TOP      3328
#define XB_TOPGEN   3392
#define XCD_BAR_WORDS 3456
#define XB_SPIN_CAP (1u << 22)
#define LAS __attribute__((address_space(3)))
DI unsigned xb_ld(unsigned* p) { return __hip_atomic_load(p, __ATOMIC_RELAXED, __HIP_MEMORY_SCOPE_AGENT); }
DI unsigned xb_add(unsigned* p, unsigned v) { return __hip_atomic_fetch_add(p, v, __ATOMIC_RELAXED, __HIP_MEMORY_SCOPE_AGENT); }
DI unsigned xb_xcc_id() { return (unsigned)__builtin_amdgcn_s_getreg((3 << 11) | 20) & 0xFu; }
#define XB_SPIN(cond, bar) do { unsigned _sp = 0; while (cond) { __builtin_amdgcn_s_sleep(1); \
    if ((++_sp & 255u) == 0u) { if (xb_ld(&(bar)[XB_TMO])) break; if (_sp > XB_SPIN_CAP) { atomicAdd(&(bar)[XB_TMO], 1u); break; } } } } while (0)
struct XcdBarrier { unsigned* bar; unsigned x; volatile LAS unsigned* st; };
DI XcdBarrier xcd_barrier_post(unsigned* bar, volatile LAS unsigned* st) {
  XcdBarrier b; b.bar = bar; b.x = xb_xcc_id(); b.st = st;
  if (threadIdx.x == 0) (void)xb_add(&bar[XB_XCNT(b.x)], 1u);
  return b;
}
DI void xcd_barrier_complete(unsigned* bar, unsigned x, unsigned& nloc, unsigned& nx) {
  const unsigned G = gridDim.x * gridDim.y * gridDim.z;
  unsigned sum, cnt, mine, sp = 0u;
  for (;;) {
    sum = 0u; cnt = 0u; mine = 0u;
#pragma unroll
    for (unsigned j = 0; j < 16; ++j) { const unsigned c = xb_ld(&bar[XB_XCNT(j)]); sum += c; cnt += (c > 0u) ? 1u : 0u; mine = (j == x) ? c : mine; }
    if (sum == G) break;
    __builtin_amdgcn_s_sleep(1);
    if ((++sp & 255u) == 0u) { if (xb_ld(&bar[XB_TMO])) break; if (sp > XB_SPIN_CAP) { atomicAdd(&bar[XB_TMO], 1u); break; } }
  }
  nloc = mine > 0u ? mine : 1u; nx = cnt > 0u ? cnt : 1u;
}
DI void xcd_barrier(const XcdBarrier& b) {
  asm volatile("s_waitcnt vmcnt(0)" ::: "memory");
  __syncthreads();
  if (threadIdx.x == 0) {
    unsigned* bar = b.bar;
    __builtin_amdgcn_s_waitcnt(0);
    unsigned nloc = b.st[0], nx = b.st[1];
    if (nloc == 0u) { xcd_barrier_complete(bar, b.x, nloc, nx); b.st[0] = nloc; b.st[1] = nx; }
    const unsigned old = xb_add(&bar[XB_XSUB(b.x)], 1u);
    const unsigned gen = old / nloc;
    if (old + 1u == (gen + 1u) * nloc) {
      __builtin_amdgcn_fence(__ATOMIC_RELEASE, "agent");
      asm volatile("s_waitcnt vmcnt(0)" ::: "memory");
      const unsigned og = xb_add(&bar[XB_TOP], 1u);
      const unsigned tg = og / nx;
      if (og + 1u == (tg + 1u) * nx) xb_add(&bar[XB_TOPGEN], 1u);
      else XB_SPIN(xb_ld(&bar[XB_TOPGEN]) == tg, bar);
      __builtin_amdgcn_fence(__ATOMIC_ACQUIRE, "agent");
      xb_add(&bar[XB_XGEN(b.x)], 1u);
      asm volatile("s_waitcnt vmcnt(0)" ::: "memory");
    } else {
      XB_SPIN(xb_ld(&bar[XB_XGEN(b.x)]) == gen, bar);
      __builtin_amdgcn_fence(__ATOMIC_ACQUIRE, "agent");
      asm volatile("s_waitcnt vmcnt(0)" ::: "memory");
    }
  }
  __syncthreads();
}

#if MULTI_LAUNCH
constexpr int NPHASE = 16;
DI void run_phase(const Params& p, int ph, char* smem) {
  if (ph == 0) { phase_prep(p, smem, 0, blockIdx.x, gridDim.x); phase_prep(p, smem, 1, blockIdx.x, gridDim.x); return; }
  if (ph == 15) { phase_final(p); return; }
  const int layer = (ph - 1) / 7, s = (ph - 1) % 7;
  switch (s) {
    case 0: phase_hmod(p, layer); break;
    case 1: phase_inproj(p, layer, smem); break;
    case 2: phase_mixers(p, layer, smem); break;
    case 3: phase_ssd_scan(p, layer); break;
    case 4: phase_ssd_final(p, layer, smem); break;
    case 5: phase_branch(p, layer, smem); break;
    default: phase_outproj(p, layer, smem); break;
  }
}
#endif

__global__ void __launch_bounds__(256, 2) mega_kernel(Params p) {
  __shared__ __attribute__((aligned(16))) char smem[SMEM_BYTES];
  __shared__ u32x4 xb_words;
  if (threadIdx.x == 0) xb_words = (u32x4){0u, 0u, 0u, 0u};
  __syncthreads();
  XcdBarrier xb = xcd_barrier_post((unsigned*)(p.ws + W_BAR), (volatile LAS unsigned*)&xb_words);
  if (p.ws == nullptr) cg::this_grid().sync();
  phase_prep(p, smem, 0, blockIdx.x, gridDim.x);
  xcd_barrier(xb);
#define LAYER_BODY(layer) \
    phase_hmod(p, layer); \
    xcd_barrier(xb); \
    phase_inproj(p, layer, smem); \
    xcd_barrier(xb); \
    phase_mixers(p, layer, smem); \
    xcd_barrier(xb); \
    phase_ssd_scan(p, layer); \
    xcd_barrier(xb); \
    phase_ssd_final(p, layer, smem); \
    if (layer == 0) { \
      const int nidle = (int)gridDim.x - 320; \
      if (nidle > 0) { \
        if ((int)blockIdx.x >= 320) phase_prep(p, smem, 1, blockIdx.x - 320, nidle, 0, 11 * nidle); \
        else phase_prep(p, smem, 1, blockIdx.x, 320, 11 * nidle, N_DEF); \
      } else phase_prep(p, smem, 1, blockIdx.x, gridDim.x); \
    } \
    xcd_barrier(xb); \
    phase_branch(p, layer, smem); \
    xcd_barrier(xb); \
    phase_outproj(p, layer, smem); \
    xcd_barrier(xb);
  LAYER_BODY(0)
  LAYER_BODY(1)
#undef LAYER_BODY
  phase_final(p);
}

#if MULTI_LAUNCH
__global__ void __launch_bounds__(256, 2) phase_kernel(Params p, int ph) {
  __shared__ __attribute__((aligned(16))) char smem[SMEM_BYTES];
  run_phase(p, ph, smem);
}
#endif

extern "C" void kernel_launch(void* const* d_in, const int* in_sizes, int n_in, void* d_out, int out_size, void* d_ws,
                              size_t ws_size, hipStream_t stream) {
  Params p{};
  const float** pp = (const float**)&p;
  for (int i = 0; i < 30; ++i) pp[i] = (const float*)d_in[i];
  p.out = (float*)d_out;
  p.ws = (char*)d_ws;
  if (ws_size < W_END) { fprintf(stderr, "workspace too small: %zu < %zu\n", ws_size, (size_t)W_END); return; }
#if MULTI_LAUNCH
  for (int ph = 0; ph < NPHASE; ++ph) hipLaunchKernelGGL(phase_kernel, dim3(512), dim3(256), 0, stream, p, ph);
#else
  static int grid_blocks = 0;
  if (!grid_blocks) {
    int dev = 0, cus = 0, per_cu = 0;
    hipGetDevice(&dev);
    hipDeviceGetAttribute(&cus, hipDeviceAttributeMultiprocessorCount, dev);
    hipOccupancyMaxActiveBlocksPerMultiprocessor(&per_cu, mega_kernel, 256, 0);
    if (per_cu > 2) per_cu = 2;
    grid_blocks = cus * per_cu;
  }
  (void)hipMemsetAsync((char*)d_ws + W_BAR, 0, 16384, stream);
  void* args[] = {&p};
  hipError_t e = hipLaunchCooperativeKernel((void*)mega_kernel, dim3(grid_blocks), dim3(256), args, 0, stream);
  if (e != hipSuccess) fprintf(stderr, "cooperative launch failed: %s (grid %d)\n", hipGetErrorString(e), grid_blocks);
#endif
}
```

```cpp
#include <hip/hip_runtime.h>
#include <hip/hip_cooperative_groups.h>
#include <stdint.h>
#include <stdio.h>
namespace cg = cooperative_groups;

#ifndef MULTI_LAUNCH
#define MULTI_LAUNCH 0
#endif

#define DI __device__ __forceinline__
typedef unsigned short bf16_t;
typedef short bf16x8 __attribute__((ext_vector_type(8)));
typedef float f32x4 __attribute__((ext_vector_type(4)));
typedef unsigned u32x4 __attribute__((ext_vector_type(4)));
typedef unsigned u32x2 __attribute__((ext_vector_type(2)));

constexpr int DM = 1024;
constexpr int NCTX = 8192;
constexpr int NLAT = 2048;
constexpr int MTOK = NCTX + NLAT;
constexpr int INC = 8464;
constexpr int NPAD = 8576;
constexpr int LDP = 7424;
constexpr int PC_QA = 0, PC_KA = 512, PC_GA = 1024, PC_Z = 1536, PC_XBC = 2048, PC_QC = 2816, PC_KC = 3328, PC_GC = 3840, PC_MG = 4352;
constexpr float EPS = 1e-6f;

constexpr size_t O_YP = 0;
constexpr size_t O_DK = 10485760;
constexpr size_t O_DV = 18874368;
constexpr size_t O_NK = 27262976;
constexpr size_t O_NV = 35651584;
constexpr size_t O_SS = 44040192;

constexpr size_t W_WTIN = 0;
constexpr size_t W_WTBR = W_WTIN + (size_t)2 * NPAD * 1024 * 2;
constexpr size_t W_WTOUT = W_WTBR + (size_t)2 * 3 * 1024 * 512 * 2;
constexpr size_t W_CKA = W_WTOUT + (size_t)2 * 1024 * 1024 * 2;
constexpr size_t W_CVTA = W_CKA + 2097152;
constexpr size_t W_CKC = W_CVTA + 2097152;
constexpr size_t W_CVTC = W_CKC + 2097152;
constexpr size_t W_ADA = W_CVTC + 2097152;
constexpr size_t W_ROPE = W_ADA + 73728;
constexpr size_t W_LAM = W_ROPE + 8192;
constexpr size_t W_PARTS = W_LAM + 256;
constexpr size_t W_VAT = W_PARTS + (size_t)MTOK * LDP * 2;
constexpr size_t W_VCT = W_VAT + (size_t)512 * MTOK * 2;
constexpr size_t W_DT = W_VCT + (size_t)512 * MTOK * 2;
constexpr size_t W_HMOD = W_DT + (size_t)MTOK * 16 * 4;
constexpr size_t W_YBF = W_HMOD + (size_t)MTOK * 1024 * 2;
constexpr size_t W_YBB = W_YBF + (size_t)MTOK * 512 * 2;
constexpr size_t W_BAR = W_YBB + (size_t)MTOK * 512 * 2;
constexpr size_t W_EA = W_BAR + 16384;
constexpr size_t W_CC = W_EA + (size_t)MTOK * 16 * 4;
constexpr size_t W_RSTD = W_CC + (size_t)MTOK * 128 * 2;
constexpr size_t W_END = W_RSTD + (size_t)MTOK * 4;

constexpr int SMEM_BYTES = 73728;
constexpr int LS = 72;

struct Params {
  const float *x_prompt, *x_sample, *cache_dk, *cache_dv, *cache_nk, *cache_nv, *state_ssd, *cvec, *c_ctx;
  const float *norm_g, *w_ada, *b_ada, *w_in, *lam_q1, *lam_k1, *lam_q2, *lam_k2, *subln_g, *conv_w, *conv_b;
  const float *dt_bias, *a_log, *d_skip, *ssd_norm_g, *na_rpb, *w_br_a, *w_br_b, *w_br_c, *w_out, *final_g;
  float* out;
  char* ws;
};

DI bf16_t f2bf(float x) { unsigned u = __float_as_uint(x); u += 0x7fffu + ((u >> 16) & 1u); return (bf16_t)(u >> 16); }
DI float bf2f(bf16_t h) { return __uint_as_float(((unsigned)h) << 16); }
DI unsigned pack2(float a, float b) { return (unsigned)f2bf(a) | ((unsigned)f2bf(b) << 16); }
DI float bflo(unsigned u) { return __uint_as_float(u << 16); }
DI float bfhi(unsigned u) { return __uint_as_float(u & 0xffff0000u); }
DI float siluf(float x) { return x / (1.f + __expf(-x)); }
DI float sigmf(float x) { return 1.f / (1.f + __expf(-x)); }
DI float wave_sum(float v) {
#pragma unroll
  for (int o = 32; o > 0; o >>= 1) v += __shfl_xor(v, o);
  return v;
}
DI void unpack8(const u32x4& v, float* f) {
  f[0] = bflo(v.x); f[1] = bfhi(v.x); f[2] = bflo(v.y); f[3] = bfhi(v.y);
  f[4] = bflo(v.z); f[5] = bfhi(v.z); f[6] = bflo(v.w); f[7] = bfhi(v.w);
}
DI f32x4 mfma16(bf16x8 a, bf16x8 b, f32x4 c) { return __builtin_amdgcn_mfma_f32_16x16x32_bf16(a, b, c, 0, 0, 0); }
DI bf16x8 lds_frag(const bf16_t* s, int row, int k) { return *(const bf16x8*)(s + row * LS + k); }
DI int get_tid() { int t = threadIdx.x; asm volatile("" : "+v"(t)); return t; }
DI float lam_init_of(int layer) { return layer == 0 ? 0.2f : (0.8f - 0.6f * 0.7408182206817179f); }

DI void transpose_tile(const float* __restrict__ src, int ld, int R0, int C0, int Cmax, bf16_t* __restrict__ dst, int ld_dst,
                       bool perm_in, float* tile) {
  const int tid = get_tid();
#pragma unroll
  for (int i = 0; i < 4; ++i) {
    int idx = tid + 256 * i, r = idx >> 4, c4 = (idx & 15) * 4;
    f32x4 v = (f32x4){0.f, 0.f, 0.f, 0.f};
    if (C0 + c4 < Cmax) v = __builtin_nontemporal_load((const f32x4*)(src + (size_t)(R0 + r) * ld + C0 + c4));
    float* t = tile + r * 65 + c4;
    t[0] = v[0]; t[1] = v[1]; t[2] = v[2]; t[3] = v[3];
  }
  __syncthreads();
#pragma unroll
  for (int i = 0; i < 2; ++i) {
    int idx = tid + 256 * i, cc = idx >> 3, kc = (idx & 7) * 8;
    int n = C0 + cc;
    if (n < Cmax) {
      int nrow = n;
      if (perm_in) nrow = (n < 3328) ? n : (n < 3344 ? 8448 + (n - 3328) : n - 16);
      u32x4 w;
      w.x = pack2(tile[(kc + 0) * 65 + cc], tile[(kc + 1) * 65 + cc]);
      w.y = pack2(tile[(kc + 2) * 65 + cc], tile[(kc + 3) * 65 + cc]);
      w.z = pack2(tile[(kc + 4) * 65 + cc], tile[(kc + 5) * 65 + cc]);
      w.w = pack2(tile[(kc + 6) * 65 + cc], tile[(kc + 7) * 65 + cc]);
      *(u32x4*)(dst + (size_t)nrow * ld_dst + R0 + kc) = w;
    }
  }
  __syncthreads();
}

constexpr int J_ADA = 192;
constexpr int J_WIN = J_ADA + 2 * 16 * 133;
constexpr int J_WBR = J_WIN + 768;
constexpr int J_WOUT = J_WBR + 512;
constexpr int J_CV = J_WOUT + 512;
constexpr int J_CK = J_CV + 512;
constexpr int J_MISC = J_CK + 1;

constexpr int J_DEF0 = J_ADA + 16 * 133, J_DEF1 = J_WOUT, N_DEF = J_DEF1 - J_DEF0;
__device__ __forceinline__ void phase_prep(const Params& p, char* smem, int mode, int first, int stride, int lo = 0, int hi = 1 << 30) {
  const int tid = get_tid();
  float* fs = (float*)smem;
  const int njobs = min(hi, mode == 0 ? J_MISC - N_DEF : N_DEF);
  for (int idx = lo + first; idx < njobs; idx += stride) {
    const int job = mode == 0 ? (idx < J_DEF0 ? idx : idx + N_DEF) : J_DEF0 + idx;
    if (job < J_ADA) {
      const int l = job / 96, jg = job % 96;
      float* sv = fs;
      float* red = fs + 3072;
      for (int i = tid; i < 3072; i += 256) {
        int v = i >> 10, k = i & 1023;
        float x = (v == 0) ? p.c_ctx[k] : p.cvec[(v - 1) * 1024 + k];
        sv[i] = siluf(x);
      }
      __syncthreads();
      const int kq = tid >> 5, jj = tid & 31;
      const float* w = p.w_ada + (size_t)l * 1024 * 3072 + jg * 32 + jj;
      float a0 = 0.f, a1 = 0.f, a2 = 0.f;
#pragma unroll 8
      for (int k = kq * 128; k < kq * 128 + 128; ++k) {
        float wv = __builtin_nontemporal_load(w + (size_t)k * 3072);
        a0 += sv[k] * wv; a1 += sv[1024 + k] * wv; a2 += sv[2048 + k] * wv;
      }
      red[(kq * 3 + 0) * 32 + jj] = a0; red[(kq * 3 + 1) * 32 + jj] = a1; red[(kq * 3 + 2) * 32 + jj] = a2;
      __syncthreads();
      if (tid < 96) {
        int v = tid >> 5, j2 = tid & 31;
        float s = 0.f;
#pragma unroll
        for (int q = 0; q < 8; ++q) s += red[(q * 3 + v) * 32 + j2];
        int col = jg * 32 + j2;
        s += p.b_ada[l * 3072 + col];
        ((float*)(p.ws + W_ADA))[(l * 3 + v) * 3072 + col] = s;
      }
      __syncthreads();
    } else if (job < J_WIN) {
      int j = job - J_ADA; int l = j / (16 * 133); j %= (16 * 133);
      int rt = j / 133, ct = j % 133;
      transpose_tile(p.w_in + (size_t)l * 1024 * INC, INC, rt * 64, ct * 64, INC,
                     (bf16_t*)(p.ws + W_WTIN) + (size_t)l * NPAD * 1024, 1024, true, fs);
    } else if (job < J_WBR) {
      int j = job - J_WIN; int lb = j / 128; j %= 128;
      int l = lb / 3, br = lb % 3;
      int rt = j / 16, ct = j % 16;
      const float* src = (br == 0 ? p.w_br_a : (br == 1 ? p.w_br_b : p.w_br_c)) + (size_t)l * 512 * 1024;
      transpose_tile(src, 1024, rt * 64, ct * 64, 1024, (bf16_t*)(p.ws + W_WTBR) + (size_t)lb * 1024 * 512, 512, false, fs);
    } else if (job < J_WOUT) {
      int j = job - J_WBR; int l = j / 256; j %= 256;
      int rt = j / 16, ct = j % 16;
      transpose_tile(p.w_out + (size_t)l * 1024 * 1024, 1024, rt * 64, ct * 64, 1024,
                     (bf16_t*)(p.ws + W_WTOUT) + (size_t)l * 1024 * 1024, 1024, false, fs);
    } else if (job < J_CV) {
      int j = job - J_WOUT; int which = j / 256; j %= 256;
      int bl = j / 64; j %= 64;
      int rt = j / 8, ct = j % 8;
      const float* src = (which == 0 ? p.cache_dv : p.cache_nv) + (size_t)bl * 512 * 512;
      bf16_t* dst = (bf16_t*)(p.ws + (which == 0 ? W_CVTA : W_CVTC)) + (size_t)bl * 512 * 512;
      transpose_tile(src, 512, rt * 64, ct * 64, 512, dst, 512, false, fs);
    } else if (job < J_CK) {
      int j = job - J_CV; int which = j / 256; j %= 256;
      const float* src = (which == 0 ? p.cache_dk : p.cache_nk) + (size_t)j * 4096;
      bf16_t* dst = (bf16_t*)(p.ws + (which == 0 ? W_CKA : W_CKC)) + (size_t)j * 4096;
#pragma unroll
      for (int i = 0; i < 2; ++i) {
        int e = (tid + 256 * i) * 8;
        const f32x4 a = __builtin_nontemporal_load((const f32x4*)(src + e)), b = __builtin_nontemporal_load((const f32x4*)(src + e + 4));
        u32x4 w; w.x = pack2(a[0], a[1]); w.y = pack2(a[2], a[3]); w.z = pack2(b[0], b[1]); w.w = pack2(b[2], b[3]);
        *(u32x4*)(dst + e) = w;
      }
    } else {
      float2* rope = (float2*)(p.ws + W_ROPE);
      for (int i = tid; i < 1024; i += 256) {
        int pos = i >> 4, fi = i & 15;
        float inv = exp2f(-(float)fi * (13.287712379549449f / 16.f));
        float ang = (float)pos * inv;
        rope[i] = make_float2(cosf(ang), sinf(ang));
      }
      if (tid < 2) {
        int l = tid;
        float s1 = 0.f, s2 = 0.f;
        for (int k = 0; k < 64; ++k) {
          s1 += p.lam_q1[l * 64 + k] * p.lam_k1[l * 64 + k];
          s2 += p.lam_q2[l * 64 + k] * p.lam_k2[l * 64 + k];
        }
        ((float*)(p.ws + W_LAM))[l] = expf(s1) - expf(s2) + lam_init_of(l);
      }
    }
  }
}

__device__ __forceinline__ void phase_hmod(const Params& p, int layer) {
  const int lane = get_tid() & 63, wave = __builtin_amdgcn_readfirstlane(get_tid() >> 6);
  const int gw = blockIdx.x * 4 + wave, nw = gridDim.x * 4;
  bf16_t* hm = (bf16_t*)(p.ws + W_HMOD);
  const float* ng = p.norm_g + layer * 1024;
  f32x4 xn[4];
  {
    const int row = min(gw, MTOK - 1);
    const float* x = (layer == 0) ? (row < NCTX ? p.x_prompt + (size_t)row * 1024 : p.x_sample + (size_t)(row - NCTX) * 1024)
                                  : p.out + (size_t)row * 1024;
#pragma unroll
    for (int i = 0; i < 4; ++i) xn[i] = *(const f32x4*)(x + (i * 64 + lane) * 4);
  }
  for (int row = gw; row < MTOK; row += nw) {
    const int v = row < NCTX ? 0 : 1 + ((row - NCTX) >> 10);
    const float* ada = (const float*)(p.ws + W_ADA) + (layer * 3 + v) * 3072;
    float4 xv[4];
    float ss = 0.f;
#pragma unroll
    for (int i = 0; i < 4; ++i) {
      xv[i] = make_float4(xn[i][0], xn[i][1], xn[i][2], xn[i][3]);
      ss += xv[i].x * xv[i].x + xv[i].y * xv[i].y + xv[i].z * xv[i].z + xv[i].w * xv[i].w;
    }
    {
      const int rn = min(row + nw, MTOK - 1);
      const float* x2 = (layer == 0) ? (rn < NCTX ? p.x_prompt + (size_t)rn * 1024 : p.x_sample + (size_t)(rn - NCTX) * 1024)
                                     : p.out + (size_t)rn * 1024;
#pragma unroll
      for (int i = 0; i < 4; ++i) xn[i] = *(const f32x4*)(x2 + (i * 64 + lane) * 4);
    }
    ss = wave_sum(ss);
    const float rstd = rsqrtf(ss * (1.f / 1024.f) + EPS);
#pragma unroll
    for (int i = 0; i < 4; ++i) {
      int col = (i * 64 + lane) * 4;
      float4 g = *(const float4*)(ng + col);
      float4 sh = *(const float4*)(ada + col);
      float4 sc = *(const float4*)(ada + 1024 + col);
      float h0 = xv[i].x * rstd * g.x * (1.f + sc.x) + sh.x;
      float h1 = xv[i].y * rstd * g.y * (1.f + sc.y) + sh.y;
      float h2 = xv[i].z * rstd * g.z * (1.f + sc.z) + sh.z;
      float h3 = xv[i].w * rstd * g.w * (1.f + sc.w) + sh.w;
      u32x2 w; w.x = pack2(h0, h1); w.y = pack2(h2, h3);
      *(u32x2*)(hm + (size_t)row * 1024 + col) = w;
    }
  }
}

template <int MT, int NT, int DEPTH, bool PERMB = false>
DI void gemm_mainloop(const bf16_t* __restrict__ Ag, int lda, const bf16_t* __restrict__ Bg, int ldb, int K,
                      f32x4 (&acc)[MT][NT], bf16_t* sA, bf16_t* sB) {
  const int tid = get_tid(), lane = tid & 63, wave = __builtin_amdgcn_readfirstlane(tid >> 6), wm = wave >> 1, wn = wave & 1, c = lane & 15, g = lane >> 4;
  u32x4 ra0[MT], rb0[NT], ra1[MT], rb1[NT];
  const int lr = tid >> 3, lk = (tid & 7) * 8;
  const int lrb = PERMB ? 16 * ((lr >> 2) & 1) + 4 * ((lr >> 3) & 3) + (lr & 3) : lr;
  const bf16_t* ap = Ag + (size_t)lr * lda + lk;
  const bf16_t* bp = Bg + (size_t)lr * ldb + lk;
#define GLOAD(RA, RB, K0) { _Pragma("unroll") for (int i = 0; i < MT; ++i) RA[i] = *(const u32x4*)(ap + (size_t)(32 * i) * lda + (K0)); \
                            _Pragma("unroll") for (int i = 0; i < NT; ++i) RB[i] = *(const u32x4*)(bp + (size_t)(32 * i) * ldb + (K0)); }
#define LSTORE(RA, RB) { _Pragma("unroll") for (int i = 0; i < MT; ++i) *(u32x4*)(sA + (lr + 32 * i) * LS + lk) = RA[i]; \
                         _Pragma("unroll") for (int i = 0; i < NT; ++i) *(u32x4*)(sB + (lrb + 32 * i) * LS + lk) = RB[i]; }
#define COMPUTE() { _Pragma("unroll") for (int ks = 0; ks < 2; ++ks) { bf16x8 xf[MT], wf[NT]; \
      _Pragma("unroll") for (int t = 0; t < MT; ++t) xf[t] = lds_frag(sA, 16 * MT * wm + 16 * t + c, 32 * ks + 8 * g); \
      _Pragma("unroll") for (int t = 0; t < NT; ++t) wf[t] = lds_frag(sB, 16 * NT * wn + 16 * t + c, 32 * ks + 8 * g); \
      _Pragma("unroll") for (int mt = 0; mt < MT; ++mt) _Pragma("unroll") for (int nt = 0; nt < NT; ++nt) acc[mt][nt] = mfma16(wf[nt], xf[mt], acc[mt][nt]); } }
  const int nk = K >> 6;
  if (DEPTH == 2) {
    GLOAD(ra0, rb0, 0);
    GLOAD(ra1, rb1, 64);
    for (int kt = 0; kt < nk; kt += 2) {
      __syncthreads();
      LSTORE(ra0, rb0);
      __syncthreads();
      if (kt + 2 < nk) GLOAD(ra0, rb0, (kt + 2) << 6);
      COMPUTE();
      __syncthreads();
      LSTORE(ra1, rb1);
      __syncthreads();
      if (kt + 3 < nk) GLOAD(ra1, rb1, (kt + 3) << 6);
      COMPUTE();
    }
  } else {
    GLOAD(ra0, rb0, 0);
    for (int kt = 0; kt < nk; ++kt) {
      __syncthreads();
      LSTORE(ra0, rb0);
      __syncthreads();
      if (kt + 1 < nk) GLOAD(ra0, rb0, (kt + 1) << 6);
      COMPUTE();
    }
  }
#undef GLOAD
#undef LSTORE
#undef COMPUTE
}

template <int MT, int NT>
DI void zero_acc(f32x4 (&acc)[MT][NT]) {
#pragma unroll
  for (int a = 0; a < MT; ++a)
#pragma unroll
    for (int b = 0; b < NT; ++b) acc[a][b] = (f32x4){0.f, 0.f, 0.f, 0.f};
}

DI void lds_read_frags(bf16x8 (&x)[4], bf16x8 (&w)[4], unsigned aA, unsigned aB, int ks) {
  if (ks == 0)
    asm volatile("ds_read_b128 %0, %8\n\tds_read_b128 %1, %8 offset:2304\n\tds_read_b128 %2, %8 offset:4608\n\tds_read_b128 %3, %8 offset:6912\n\t"
                 "ds_read_b128 %4, %9\n\tds_read_b128 %5, %9 offset:2304\n\tds_read_b128 %6, %9 offset:4608\n\tds_read_b128 %7, %9 offset:6912\n\t"
                 "s_waitcnt lgkmcnt(0)"
                 : "=&v"(x[0]), "=&v"(x[1]), "=&v"(x[2]), "=&v"(x[3]), "=&v"(w[0]), "=&v"(w[1]), "=&v"(w[2]), "=&v"(w[3])
                 : "v"(aA), "v"(aB) : "memory");
  else
    asm volatile("ds_read_b128 %0, %8 offset:64\n\tds_read_b128 %1, %8 offset:2368\n\tds_read_b128 %2, %8 offset:4672\n\tds_read_b128 %3, %8 offset:6976\n\t"
                 "ds_read_b128 %4, %9 offset:64\n\tds_read_b128 %5, %9 offset:2368\n\tds_read_b128 %6, %9 offset:4672\n\tds_read_b128 %7, %9 offset:6976\n\t"
                 "s_waitcnt lgkmcnt(0)"
                 : "=&v"(x[0]), "=&v"(x[1]), "=&v"(x[2]), "=&v"(x[3]), "=&v"(w[0]), "=&v"(w[1]), "=&v"(w[2]), "=&v"(w[3])
                 : "v"(aA), "v"(aB) : "memory");
}
DI void lds_read_frags(bf16x8 (&x)[5], bf16x8 (&w)[2], unsigned aA, unsigned aB, int ks) {
  if (ks == 0)
    asm volatile("ds_read_b128 %0, %7\n\tds_read_b128 %1, %7 offset:2304\n\tds_read_b128 %2, %7 offset:4608\n\tds_read_b128 %3, %7 offset:6912\n\tds_read_b128 %4, %7 offset:9216\n\t"
                 "ds_read_b128 %5, %8\n\tds_read_b128 %6, %8 offset:2304\n\t"
                 "s_waitcnt lgkmcnt(0)"
                 : "=&v"(x[0]), "=&v"(x[1]), "=&v"(x[2]), "=&v"(x[3]), "=&v"(x[4]), "=&v"(w[0]), "=&v"(w[1])
                 : "v"(aA), "v"(aB) : "memory");
  else
    asm volatile("ds_read_b128 %0, %7 offset:64\n\tds_read_b128 %1, %7 offset:2368\n\tds_read_b128 %2, %7 offset:4672\n\tds_read_b128 %3, %7 offset:6976\n\tds_read_b128 %4, %7 offset:9280\n\t"
                 "ds_read_b128 %5, %8 offset:64\n\tds_read_b128 %6, %8 offset:2368\n\t"
                 "s_waitcnt lgkmcnt(0)"
                 : "=&v"(x[0]), "=&v"(x[1]), "=&v"(x[2]), "=&v"(x[3]), "=&v"(x[4]), "=&v"(w[0]), "=&v"(w[1])
                 : "v"(aA), "v"(aB) : "memory");
}

DI void lds_issue_frags1(bf16x8 (&x)[4], bf16x8 (&w)[4], unsigned aA, unsigned aB) {
  asm volatile("ds_read_b128 %0, %8 offset:64\n\tds_read_b128 %1, %8 offset:2368\n\tds_read_b128 %2, %8 offset:4672\n\tds_read_b128 %3, %8 offset:6976\n\t"
               "ds_read_b128 %4, %9 offset:64\n\tds_read_b128 %5, %9 offset:2368\n\tds_read_b128 %6, %9 offset:4672\n\tds_read_b128 %7, %9 offset:6976"
               : "=&v"(x[0]), "=&v"(x[1]), "=&v"(x[2]), "=&v"(x[3]), "=&v"(w[0]), "=&v"(w[1]), "=&v"(w[2]), "=&v"(w[3])
               : "v"(aA), "v"(aB) : "memory");
}
DI void lds_wait_frags(bf16x8 (&x)[4], bf16x8 (&w)[4], f32x4& a0, f32x4& a1, f32x4& a2, f32x4& a3) {
  asm volatile("s_waitcnt lgkmcnt(0)"
               : "+v"(x[0]), "+v"(x[1]), "+v"(x[2]), "+v"(x[3]), "+v"(w[0]), "+v"(w[1]), "+v"(w[2]), "+v"(w[3]),
                 "+v"(a0), "+v"(a1), "+v"(a2), "+v"(a3) :: "memory");
}
DI void lds_issue_frags1(bf16x8 (&x)[5], bf16x8 (&w)[2], unsigned aA, unsigned aB) { lds_read_frags(x, w, aA, aB, 1); }
DI void lds_wait_frags(bf16x8 (&x)[5], bf16x8 (&w)[2], f32x4& a0, f32x4& a1, f32x4& a2, f32x4& a3) {}

template <int MT, int NT, bool PERMB = false>
DI void gemm_mainloop_dma(const bf16_t* __restrict__ Ag, int lda, const bf16_t* __restrict__ Bg, int ldb, int K,
                          f32x4 (&acc)[MT][NT], char* smem) {
  constexpr int RA = 32 * MT, RB = 32 * NT, ROWS = RA + RB, NCH = ROWS * 9, NI = (NCH + 255) / 256, BUF = NI * 4096;
  static_assert(2 * BUF <= SMEM_BYTES, "LDS");
  const int tid = get_tid(), lane = tid & 63, wave = __builtin_amdgcn_readfirstlane(tid >> 6), wm = wave >> 1, wn = wave & 1, c = lane & 15, g = lane >> 4;
  const bf16_t* src[NI];
#pragma unroll
  for (int i = 0; i < NI; ++i) {
    const int q = tid + 256 * i;
    int row = q / 9, cc = q - row * 9;
    row = min(row, ROWS - 1); cc = min(cc, 7);
    int rb = row - RA;
    if (PERMB) { const int t = (rb >> 4) & 3, c4 = rb & 15; rb = (rb & ~63) + 32 * (t >> 1) + 8 * (c4 >> 2) + 4 * (t & 1) + (c4 & 3); }
    src[i] = (row < RA ? Ag + (size_t)row * lda : Bg + (size_t)rb * ldb) + cc * 8;
  }
#define DMA_ISSUE(KT, BUFI) { _Pragma("unroll") for (int i = 0; i < NI; ++i) \
    __builtin_amdgcn_global_load_lds((const unsigned*)(src[i] + ((KT) << 6)), (unsigned*)(smem + (BUFI) * BUF + (tid + 256 * i) * 16), 16, 0, 0); }
  const int nk = K >> 6;
  const unsigned ldsA = (unsigned)(size_t)smem + (unsigned)((16 * MT * wm + c) * (LS * 2) + 16 * g);
  const unsigned ldsB = (unsigned)(size_t)smem + (unsigned)((RA + 16 * NT * wn + c) * (LS * 2) + 16 * g);
  __syncthreads();
  DMA_ISSUE(0, 0);
  asm volatile("s_waitcnt vmcnt(0)" ::: "memory");
  __syncthreads();
  for (int kt = 0; kt < nk; ++kt) {
    const int cur = kt & 1;
    if (kt + 1 < nk) DMA_ISSUE(kt + 1, cur ^ 1);
    const unsigned aA = ldsA + cur * BUF, aB = ldsB + cur * BUF;
    {
      bf16x8 xf[MT], wf[NT], xg[MT], wg[NT];
      lds_read_frags(xf, wf, aA, aB, 0);
      lds_issue_frags1(xg, wg, aA, aB);
#pragma unroll
      for (int mt = 0; mt < MT; ++mt)
#pragma unroll
        for (int nt = 0; nt < NT; ++nt) acc[mt][nt] = mfma16(wf[nt], xf[mt], acc[mt][nt]);
      lds_wait_frags(xg, wg, acc[MT - 1][0], acc[MT - 1][1], acc[MT - 1][NT - 2], acc[MT - 1][NT - 1]);
#pragma unroll
      for (int mt = 0; mt < MT; ++mt)
#pragma unroll
        for (int nt = 0; nt < NT; ++nt) acc[mt][nt] = mfma16(wg[nt], xg[mt], acc[mt][nt]);
    }
    asm volatile("s_waitcnt vmcnt(0)" : "+v"(acc[0][0]), "+v"(acc[0][NT - 1]), "+v"(acc[MT - 1][0]), "+v"(acc[MT - 1][NT - 1]) :: "memory");
    __syncthreads();
  }
#undef DMA_ISSUE
}

DI void lds_read_frags_sw(bf16x8 (&x)[5], bf16x8 (&w)[4], unsigned aA, unsigned aB) {
  asm volatile("ds_read_b128 %0, %9\n\tds_read_b128 %1, %9 offset:2048\n\tds_read_b128 %2, %9 offset:4096\n\tds_read_b128 %3, %9 offset:6144\n\tds_read_b128 %4, %9 offset:8192\n\t"
               "ds_read_b128 %5, %10\n\tds_read_b128 %6, %10 offset:2048\n\tds_read_b128 %7, %10 offset:4096\n\tds_read_b128 %8, %10 offset:6144\n\t"
               "s_waitcnt lgkmcnt(0)"
               : "=&v"(x[0]), "=&v"(x[1]), "=&v"(x[2]), "=&v"(x[3]), "=&v"(x[4]), "=&v"(w[0]), "=&v"(w[1]), "=&v"(w[2]), "=&v"(w[3])
               : "v"(aA), "v"(aB) : "memory");
}
DI void lds_read_frags_sw(bf16x8 (&x)[5], bf16x8 (&w)[2], unsigned aA, unsigned aB) {
  asm volatile("ds_read_b128 %0, %7\n\tds_read_b128 %1, %7 offset:2048\n\tds_read_b128 %2, %7 offset:4096\n\tds_read_b128 %3, %7 offset:6144\n\tds_read_b128 %4, %7 offset:8192\n\t"
               "ds_read_b128 %5, %8\n\tds_read_b128 %6, %8 offset:2048\n\t"
               "s_waitcnt lgkmcnt(0)"
               : "=&v"(x[0]), "=&v"(x[1]), "=&v"(x[2]), "=&v"(x[3]), "=&v"(x[4]), "=&v"(w[0]), "=&v"(w[1])
               : "v"(aA), "v"(aB) : "memory");
}
template <bool PERMB, int NT = 4>
DI void gemm_mainloop_dma_sw(const bf16_t* __restrict__ Ag, int lda, const bf16_t* __restrict__ Bg, int ldb, int K,
                             f32x4 (&acc)[5][NT], char* smem) {
  constexpr int MT = 5, RA = 32 * MT, RB = 32 * NT, ROWS = RA + RB, NI = ROWS * 8 / 256, BUF = ROWS * 128;
  static_assert(ROWS * 8 % 256 == 0 && 2 * BUF <= SMEM_BYTES, "LDS");
  const int tid = get_tid(), lane = tid & 63, wave = __builtin_amdgcn_readfirstlane(tid >> 6), wm = wave >> 1, wn = wave & 1, c = lane & 15, g = lane >> 4;
  const bf16_t* src[NI];
#pragma unroll
  for (int i = 0; i < NI; ++i) {
    const int q = tid + 256 * i;
    const int row = q >> 3, x = (q & 7) ^ ((row >> 1) & 7);
    int rb = row - RA;
    if (PERMB && NT == 4) { const int t = (rb >> 4) & 3, c4 = rb & 15; rb = (rb & ~63) + 32 * (t >> 1) + 8 * (c4 >> 2) + 4 * (t & 1) + (c4 & 3); }
    if (PERMB && NT == 2) { const int t = (rb >> 4) & 1, c4 = rb & 15; rb = (rb & ~31) + 8 * (c4 >> 2) + 4 * t + (c4 & 3); }
    src[i] = (row < RA ? Ag + (size_t)row * lda : Bg + (size_t)rb * ldb) + x * 8;
  }
#define DMA_ISSUE(KT, BUFI) { _Pragma("unroll") for (int i = 0; i < NI; ++i) \
    __builtin_amdgcn_global_load_lds((const unsigned*)(src[i] + ((KT) << 6)), (unsigned*)(smem + (BUFI) * BUF + (tid + 256 * i) * 16), 16, 0, 0); }
  const int nk = K >> 6;
  const unsigned f = (unsigned)((c >> 1) & 7);
  const unsigned off0 = ((unsigned)g ^ f) * 16u, off1 = off0 ^ 64u;
  const unsigned rowA = (unsigned)(size_t)smem + (unsigned)((16 * MT * wm + c) * 128);
  const unsigned rowB = (unsigned)(size_t)smem + (unsigned)((RA + 16 * NT * wn + c) * 128);
  __syncthreads();
  DMA_ISSUE(0, 0);
  asm volatile("s_waitcnt vmcnt(0)" ::: "memory");
  __syncthreads();
  for (int kt = 0; kt < nk; ++kt) {
    const int cur = kt & 1;
    if (kt + 1 < nk) DMA_ISSUE(kt + 1, cur ^ 1);
    {
      bf16x8 xf[MT], wf[NT];
      lds_read_frags_sw(xf, wf, rowA + cur * BUF + off0, rowB + cur * BUF + off0);
#pragma unroll
      for (int mt = 0; mt < MT; ++mt)
#pragma unroll
        for (int nt = 0; nt < NT; ++nt) acc[mt][nt] = mfma16(wf[nt], xf[mt], acc[mt][nt]);
    }
    {
      bf16x8 xf[MT], wf[NT];
      lds_read_frags_sw(xf, wf, rowA + cur * BUF + off1, rowB + cur * BUF + off1);
#pragma unroll
      for (int mt = 0; mt < MT; ++mt)
#pragma unroll
        for (int nt = 0; nt < NT; ++nt) acc[mt][nt] = mfma16(wf[nt], xf[mt], acc[mt][nt]);
    }
    asm volatile("s_waitcnt vmcnt(0)" : "+v"(acc[0][0]), "+v"(acc[0][NT - 1]), "+v"(acc[MT - 1][0]), "+v"(acc[MT - 1][NT - 1]) :: "memory");
    __syncthreads();
  }
#undef DMA_ISSUE
}

DI void lds_read_frags_sw(bf16x8 (&x)[4], bf16x8 (&w)[4], unsigned aA, unsigned aB) {
  asm volatile("ds_read_b128 %0, %8\n\tds_read_b128 %1, %8 offset:2048\n\tds_read_b128 %2, %8 offset:4096\n\tds_read_b128 %3, %8 offset:6144\n\t"
               "ds_read_b128 %4, %9\n\tds_read_b128 %5, %9 offset:2048\n\tds_read_b128 %6, %9 offset:4096\n\tds_read_b128 %7, %9 offset:6144\n\t"
               "s_waitcnt lgkmcnt(0)"
               : "=&v"(x[0]), "=&v"(x[1]), "=&v"(x[2]), "=&v"(x[3]), "=&v"(w[0]), "=&v"(w[1]), "=&v"(w[2]), "=&v"(w[3])
               : "v"(aA), "v"(aB) : "memory");
}
DI void lds_issue_frags_sw(bf16x8 (&x)[4], bf16x8 (&w)[4], unsigned aA, unsigned aB) {
  asm volatile("ds_read_b128 %0, %8\n\tds_read_b128 %1, %8 offset:2048\n\tds_read_b128 %2, %8 offset:4096\n\tds_read_b128 %3, %8 offset:6144\n\t"
               "ds_read_b128 %4, %9\n\tds_read_b128 %5, %9 offset:2048\n\tds_read_b128 %6, %9 offset:4096\n\tds_read_b128 %7, %9 offset:6144"
               : "=&v"(x[0]), "=&v"(x[1]), "=&v"(x[2]), "=&v"(x[3]), "=&v"(w[0]), "=&v"(w[1]), "=&v"(w[2]), "=&v"(w[3])
               : "v"(aA), "v"(aB) : "memory");
}
DI void gemm_mainloop_dma_sw44(const bf16_t* __restrict__ Ag, int lda, const bf16_t* __restrict__ Bg, int ldb, int K,
                               f32x4 (&acc)[4][4], char* smem) {
  constexpr int MT = 4, NT = 4, RA = 128, ROWS = 256, NI = 8, BUF = ROWS * 128;
  const int tid = get_tid(), lane = tid & 63, wave = __builtin_amdgcn_readfirstlane(tid >> 6), wm = wave >> 1, wn = wave & 1, c = lane & 15, g = lane >> 4;
  const bf16_t* src[NI];
#pragma unroll
  for (int i = 0; i < NI; ++i) {
    const int q = tid + 256 * i;
    const int row = q >> 3, x = (q & 7) ^ ((row >> 1) & 7);
    int rb = row - RA;
    { const int t = (rb >> 4) & 3, c4 = rb & 15; rb = (rb & ~63) + 32 * (t >> 1) + 8 * (c4 >> 2) + 4 * (t & 1) + (c4 & 3); }
    src[i] = (row < RA ? Ag + (size_t)row * lda : Bg + (size_t)rb * ldb) + x * 8;
  }
#define DMA_ISSUE(KT, BUFI) { _Pragma("unroll") for (int i = 0; i < NI; ++i) \
    __builtin_amdgcn_global_load_lds((const unsigned*)(src[i] + ((KT) << 6)), (unsigned*)(smem + (BUFI) * BUF + (tid + 256 * i) * 16), 16, 0, 0); }
  const int nk = K >> 6;
  const unsigned f = (unsigned)((c >> 1) & 7);
  const unsigned off0 = ((unsigned)g ^ f) * 16u, off1 = off0 ^ 64u;
  const unsigned rowA = (unsigned)(size_t)smem + (unsigned)((16 * MT * wm + c) * 128);
  const unsigned rowB = (unsigned)(size_t)smem + (unsigned)((RA + 16 * NT * wn + c) * 128);
  __syncthreads();
  DMA_ISSUE(0, 0);
  asm volatile("s_waitcnt vmcnt(0)" ::: "memory");
  __syncthreads();
  for (int kt = 0; kt < nk; ++kt) {
    const int cur = kt & 1;
    if (kt + 1 < nk) DMA_ISSUE(kt + 1, cur ^ 1);
    const unsigned bA = rowA + cur * BUF, bB = rowB + cur * BUF;
    bf16x8 xf[MT], wf[NT], xg[MT], wg[NT];
    lds_read_frags_sw(xf, wf, bA + off0, bB + off0);
    lds_issue_frags_sw(xg, wg, bA + off1, bB + off1);
#pragma unroll
    for (int mt = 0; mt < MT; ++mt)
#pragma unroll
      for (int nt = 0; nt < NT; ++nt) acc[mt][nt] = mfma16(wf[nt], xf[mt], acc[mt][nt]);
    lds_wait_frags(xg, wg, acc[MT - 1][0], acc[MT - 1][1], acc[MT - 1][NT - 2], acc[MT - 1][NT - 1]);
#pragma unroll
    for (int mt = 0; mt < MT; ++mt)
#pragma unroll
      for (int nt = 0; nt < NT; ++nt) acc[mt][nt] = mfma16(wg[nt], xg[mt], acc[mt][nt]);
    asm volatile("s_waitcnt vmcnt(0)" : "+v"(acc[0][0]), "+v"(acc[0][NT - 1]), "+v"(acc[MT - 1][0]), "+v"(acc[MT - 1][NT - 1]) :: "memory");
    __syncthreads();
  }
#undef DMA_ISSUE
}

DI void lds_issue_frags_sw(bf16x8 (&x)[5], bf16x8 (&w)[4], unsigned aA, unsigned aB) {
  asm volatile("ds_read_b128 %0, %9\n\tds_read_b128 %1, %9 offset:2048\n\tds_read_b128 %2, %9 offset:4096\n\tds_read_b128 %3, %9 offset:6144\n\tds_read_b128 %4, %9 offset:8192\n\t"
               "ds_read_b128 %5, %10\n\tds_read_b128 %6, %10 offset:2048\n\tds_read_b128 %7, %10 offset:4096\n\tds_read_b128 %8, %10 offset:6144"
               : "=&v"(x[0]), "=&v"(x[1]), "=&v"(x[2]), "=&v"(x[3]), "=&v"(x[4]), "=&v"(w[0]), "=&v"(w[1]), "=&v"(w[2]), "=&v"(w[3])
               : "v"(aA), "v"(aB) : "memory");
}
DI void lds_wait_frags_sw(bf16x8 (&x)[5], bf16x8 (&w)[4], f32x4& a0, f32x4& a1, f32x4& a2, f32x4& a3) {
  asm volatile("s_waitcnt lgkmcnt(0)"
               : "+v"(x[0]), "+v"(x[1]), "+v"(x[2]), "+v"(x[3]), "+v"(x[4]), "+v"(w[0]), "+v"(w[1]), "+v"(w[2]), "+v"(w[3]),
                 "+v"(a0), "+v"(a1), "+v"(a2), "+v"(a3) :: "memory");
}
DI void gemm_mainloop_dma_sw54p(const bf16_t* __restrict__ Ag, int lda, const bf16_t* __restrict__ Bg, int ldb, int K,
                                f32x4 (&acc)[5][4], char* smem) {
  constexpr int MT = 5, NT = 4, RA = 160, ROWS = 288, NI = 9, BUF = ROWS * 128;
  const int tid = get_tid(), lane = tid & 63, wave = __builtin_amdgcn_readfirstlane(tid >> 6), wm = wave >> 1, wn = wave & 1, c = lane & 15, g = lane >> 4;
  const bf16_t* src[NI];
#pragma unroll
  for (int i = 0; i < NI; ++i) {
    const int q = tid + 256 * i;
    const int row = q >> 3, x = (q & 7) ^ ((row >> 1) & 7);
    int rb = row - RA;
    { const int t = (rb >> 4) & 3, c4 = rb & 15; rb = (rb & ~63) + 32 * (t >> 1) + 8 * (c4 >> 2) + 4 * (t & 1) + (c4 & 3); }
    src[i] = (row < RA ? Ag + (size_t)row * lda : Bg + (size_t)rb * ldb) + x * 8;
  }
#define DMA_ISSUE(KT, BUFI) { _Pragma("unroll") for (int i = 0; i < NI; ++i) \
    __builtin_amdgcn_global_load_lds((const unsigned*)(src[i] + ((KT) << 6)), (unsigned*)(smem + (BUFI) * BUF + (tid + 256 * i) * 16), 16, 0, 0); }
  const int nk = K >> 6;
  const unsigned f = (unsigned)((c >> 1) & 7);
  const unsigned off0 = ((unsigned)g ^ f) * 16u, off1 = off0 ^ 64u;
  const unsigned rowA = (unsigned)(size_t)smem + (unsigned)((16 * MT * wm + c) * 128);
  const unsigned rowB = (unsigned)(size_t)smem + (unsigned)((RA + 16 * NT * wn + c) * 128);
  __syncthreads();
  DMA_ISSUE(0, 0);
  asm volatile("s_waitcnt vmcnt(0)" ::: "memory");
  __syncthreads();
  for (int kt = 0; kt < nk; ++kt) {
    const int cur = kt & 1;
    if (kt + 1 < nk) DMA_ISSUE(kt + 1, cur ^ 1);
    const unsigned bA = rowA + cur * BUF, bB = rowB + cur * BUF;
    bf16x8 xf[MT], wf[NT], xg[MT], wg[NT];
    lds_read_frags_sw(xf, wf, bA + off0, bB + off0);
    lds_issue_frags_sw(xg, wg, bA + off1, bB + off1);
#pragma unroll
    for (int mt = 0; mt < MT; ++mt)
#pragma unroll
      for (int nt = 0; nt < NT; ++nt) acc[mt][nt] = mfma16(wf[nt], xf[mt], acc[mt][nt]);
    lds_wait_frags_sw(xg, wg, acc[MT - 1][0], acc[MT - 1][1], acc[MT - 1][NT - 2], acc[MT - 1][NT - 1]);
#pragma unroll
    for (int mt = 0; mt < MT; ++mt)
#pragma unroll
      for (int nt = 0; nt < NT; ++nt) acc[mt][nt] = mfma16(wg[nt], xg[mt], acc[mt][nt]);
    asm volatile("s_waitcnt vmcnt(0)" : "+v"(acc[0][0]), "+v"(acc[0][NT - 1]), "+v"(acc[MT - 1][0]), "+v"(acc[MT - 1][NT - 1]) :: "memory");
    __syncthreads();
  }
#undef DMA_ISSUE
}

__device__ __forceinline__ void phase_inproj(const Params& p, int layer, char* smem) {
  const int tid = get_tid(), lane = tid & 63, wave = __builtin_amdgcn_readfirstlane(tid >> 6), wm = wave >> 1, wn = wave & 1, c = lane & 15, g = lane >> 4;
  const bf16_t* hm = (const bf16_t*)(p.ws + W_HMOD);
  const bf16_t* wt = (const bf16_t*)(p.ws + W_WTIN) + (size_t)layer * NPAD * 1024;
  bf16_t* parts = (bf16_t*)(p.ws + W_PARTS);
  const float2* rope = (const float2*)(p.ws + W_ROPE);
  const int ntiles = 64 * 67;
  for (int t = blockIdx.x; t < ntiles; t += gridDim.x) {
    const int m0 = (t % 64) * 160, n0 = (t / 64) * 128;
    f32x4 acc[5][4];
    zero_acc<5, 4>(acc);
    gemm_mainloop_dma_sw54p(hm + (size_t)m0 * 1024, 1024, wt + (size_t)n0 * 1024, 1024, 1024, acc, smem);
    const int nb = n0 + 64 * wn;
    const int mb = m0 + 80 * wm;
    if (nb >= 8448) {
      if (nb == 8448 && g < 2) {
        float* dt = (float*)(p.ws + W_DT);
#pragma unroll
        for (int mt = 0; mt < 5; ++mt) {
          const int tok = mb + 16 * mt + c;
          *(f32x4*)(dt + (size_t)tok * 16 + 8 * g) = acc[mt][0];
          *(f32x4*)(dt + (size_t)tok * 16 + 8 * g + 4) = acc[mt][1];
        }
      }
      continue;
    }
    const bool is_qa = nb < 512, is_ka = nb >= 512 && nb < 1024;
    const bool is_va = nb >= 1024 && nb < 1536, is_vc = nb >= 4352 && nb < 4864;
    const bool is_kc = nb >= 3840 && nb < 4352, is_qc = nb >= 3328 && nb < 3840;
    if (is_qa || is_ka) {
      const int fi = 8 * (g & 1);
      const float sgn = (g < 2) ? -1.f : 1.f;
#pragma unroll
      for (int mt = 0; mt < 5; ++mt) {
        if (mb + 16 * mt >= NCTX) {
          const int tl = (mb + 16 * mt + c - NCTX) & 1023;
          const int prow = tl >> 6, pcol = tl & 63;
#pragma unroll
          for (int nt = 0; nt < 4; ++nt) {
            const int pos = (nt >> 1) ? pcol : prow;
#pragma unroll
            for (int r = 0; r < 4; ++r) {
              const float2 cs = rope[pos * 16 + fi + 4 * (nt & 1) + r];
              const float own = acc[mt][nt][r];
              const float oth = __shfl_xor(own, 32);
              acc[mt][nt][r] = own * cs.x + sgn * oth * cs.y;
            }
          }
        }
      }
    }
    if (is_ka || is_va || is_kc || is_vc) {
      size_t obase; int cseg;
      if (is_ka) { obase = O_DK; cseg = nb - 512; }
      else if (is_va) { obase = O_DV; cseg = nb - 1024; }
      else if (is_kc) { obase = O_NK; cseg = nb - 3840; }
      else { obase = O_NV; cseg = nb - 4352; }
#pragma unroll
      for (int mt = 0; mt < 5; ++mt) {
        if (mb + 16 * mt < NCTX) {
          const int tok = mb + 16 * mt + c;
          const int b = tok >> 8, tt = tok & 255;
          float* o = p.out + obase + ((size_t)((b * 2 + layer) * 256 + tt)) * 512 + cseg + 8 * g;
#pragma unroll
          for (int q = 0; q < 2; ++q) { __builtin_nontemporal_store(acc[mt][2 * q], (f32x4*)(o + 32 * q)); __builtin_nontemporal_store(acc[mt][2 * q + 1], (f32x4*)(o + 32 * q + 4)); }
        }
      }
    }
    if (is_va || is_vc) {
      bf16_t* vt = (bf16_t*)(p.ws + (is_va ? W_VAT : W_VCT));
      const int cseg = is_va ? nb - 1024 : nb - 4352;
      constexpr int TS = 88;
      bf16_t* T = (bf16_t*)smem + wave * 64 * TS;
#pragma unroll
      for (int mt = 0; mt < 5; ++mt)
#pragma unroll
        for (int nt = 0; nt < 4; ++nt)
#pragma unroll
          for (int r = 0; r < 4; ++r) T[(32 * (nt >> 1) + 8 * g + 4 * (nt & 1) + r) * TS + 16 * mt + c] = f2bf(acc[mt][nt][r]);
#pragma unroll
      for (int j = 0; j < 10; ++j) {
        const int id = lane + 64 * j, rowc = id / 10, chk = id - rowc * 10;
        const u32x4 v = *(const u32x4*)(T + rowc * TS + chk * 8);
        *(u32x4*)(vt + (size_t)(cseg + rowc) * MTOK + mb + chk * 8) = v;
      }
    } else {
      const int pcol = nb < 1024 ? nb : (nb < 4352 ? nb - 512 : nb - 1024);
      const float sc = (is_qa || is_qc) ? 0.125f : 1.f;
#pragma unroll
      for (int mt = 0; mt < 5; ++mt) {
        const int tok = mb + 16 * mt + c;
        bf16_t* o = parts + (size_t)tok * LDP + pcol + 8 * g;
#pragma unroll
        for (int q = 0; q < 2; ++q) {
          u32x4 w;
          w.x = pack2(acc[mt][2 * q][0] * sc, acc[mt][2 * q][1] * sc); w.y = pack2(acc[mt][2 * q][2] * sc, acc[mt][2 * q][3] * sc);
          w.z = pack2(acc[mt][2 * q + 1][0] * sc, acc[mt][2 * q + 1][1] * sc); w.w = pack2(acc[mt][2 * q + 1][2] * sc, acc[mt][2 * q + 1][3] * sc);
          if (nb >= 4864) __builtin_nontemporal_store(w, (u32x4*)(o + 32 * q));
          else *(u32x4*)(o + 32 * q) = w;
        }
      }
    }
  }
}

struct AttnSeg { const bf16_t* k; int ldk; const bf16_t* v; int ldv; int ntiles; };

template <int NMAP, int DV, bool WIN>
DI void attn_core(const bf16_t* __restrict__ qrow, const AttnSeg s0, const AttnSeg s1, int qc, int dr0, const float* rpb_s,
                  bf16_t* Ks, bf16_t* Vts, f32x4 (&o)[NMAP][DV / 16], float (&lsum)[NMAP]) {
  const int tid = get_tid(), lane = tid & 63, wave = __builtin_amdgcn_readfirstlane(tid >> 6), c = lane & 15, g = lane >> 4;
  constexpr int NKC = NMAP * 2;
  constexpr int NVC = DV / 32;
  bf16x8 qf[NMAP][2];
#pragma unroll
  for (int m = 0; m < NMAP; ++m)
#pragma unroll
    for (int ks = 0; ks < 2; ++ks) qf[m][ks] = *(const bf16x8*)(qrow + m * 64 + 32 * ks + 8 * g);
  float mrun[NMAP];
#pragma unroll
  for (int m = 0; m < NMAP; ++m) {
    mrun[m] = -1e30f; lsum[m] = 0.f;
#pragma unroll
    for (int e = 0; e < DV / 16; ++e) o[m][e] = (f32x4){0.f, 0.f, 0.f, 0.f};
  }
  u32x4 rk[NKC], rv[NVC];
  const int ntot = s0.ntiles + s1.ntiles;
  auto gl = [&](int kt) {
    const bool first = kt < s0.ntiles;
    const int loc = first ? kt : kt - s0.ntiles;
    const bf16_t* kp = first ? s0.k : s1.k; const int ldk = first ? s0.ldk : s1.ldk;
    const bf16_t* vp = first ? s0.v : s1.v; const int ldv = first ? s0.ldv : s1.ldv;
    kp += (size_t)loc * 64 * ldk; vp += loc * 64;
#pragma unroll
    for (int i = 0; i < NKC; ++i) {
      int id = tid + 256 * i; int key = id / (NMAP * 8), cc = id % (NMAP * 8);
      rk[i] = *(const u32x4*)(kp + (size_t)key * ldk + cc * 8);
    }
#pragma unroll
    for (int i = 0; i < NVC; ++i) {
      int id = tid + 256 * i; int e = id >> 3, kc = (id & 7) * 8;
      rv[i] = *(const u32x4*)(vp + (size_t)e * ldv + kc);
    }
  };
  gl(0);
  for (int kt = 0; kt < ntot; ++kt) {
    __syncthreads();
#pragma unroll
    for (int i = 0; i < NKC; ++i) {
      int id = tid + 256 * i; int key = id / (NMAP * 8), cc = id % (NMAP * 8);
      *(u32x4*)(Ks + ((cc >> 3) * 64 + key) * LS + (cc & 7) * 8) = rk[i];
    }
#pragma unroll
    for (int i = 0; i < NVC; ++i) {
      int id = tid + 256 * i; int e = id >> 3, kc = (id & 7) * 8;
      *(u32x4*)(Vts + e * LS + kc) = rv[i];
    }
    __syncthreads();
    if (kt + 1 < ntot) gl(kt + 1);
    const bool win = WIN && kt >= s0.ntiles;
    const int nblk = win ? 1 : 2;
    for (int T = 0; T < nblk; ++T) {
      int kb = T * 32;
      if (win) kb = (wave == 0) ? 0 : (wave == 1 ? 8 : (wave == 2 ? 24 : 32));
      bf16x8 pf[NMAP];
      float alpha[NMAP];
#pragma unroll
      for (int m = 0; m < NMAP; ++m) {
        f32x4 sa = (f32x4){0.f, 0.f, 0.f, 0.f}, sb = sa;
        const int krow = kb + 8 * (c >> 2) + (c & 3);
#pragma unroll
        for (int ks = 0; ks < 2; ++ks) {
          bf16x8 a0 = lds_frag(Ks + m * 64 * LS, krow, 32 * ks + 8 * g);
          bf16x8 a1 = lds_frag(Ks + m * 64 * LS, krow + 4, 32 * ks + 8 * g);
          sa = mfma16(a0, qf[m][ks], sa);
          sb = mfma16(a1, qf[m][ks], sb);
        }
        if (win) {
          const int dr = dr0 + (kt - s0.ntiles);
          const int cs = min(max(qc - 8, 0), 48);
#pragma unroll
          for (int r = 0; r < 4; ++r) {
            int kc0 = kb + 8 * g + r, kc1 = kc0 + 4;
            int dc0 = min(max(kc0 - qc, -15), 15) + 15, dc1 = min(max(kc1 - qc, -15), 15) + 15;
            bool v0 = kc0 >= cs && kc0 < cs + 16, v1 = kc1 >= cs && kc1 < cs + 16;
            sa[r] = v0 ? sa[r] + rpb_s[dr * 31 + dc0] : -1e30f;
            sb[r] = v1 ? sb[r] + rpb_s[dr * 31 + dc1] : -1e30f;
          }
        }
        float mx = fmaxf(fmaxf(fmaxf(sa[0], sa[1]), fmaxf(sa[2], sa[3])), fmaxf(fmaxf(sb[0], sb[1]), fmaxf(sb[2], sb[3])));
        mx = fmaxf(mx, __shfl_xor(mx, 16));
        mx = fmaxf(mx, __shfl_xor(mx, 32));
        const float mnew = fmaxf(mrun[m], mx);
        alpha[m] = __expf(mrun[m] - mnew);
        mrun[m] = mnew;
        float ps = 0.f;
#pragma unroll
        for (int r = 0; r < 4; ++r) { sa[r] = __expf(sa[r] - mnew); sb[r] = __expf(sb[r] - mnew); ps += sa[r] + sb[r]; }
        lsum[m] = lsum[m] * alpha[m] + ps;
        union { u32x4 u; bf16x8 v; } cv;
        cv.u.x = pack2(sa[0], sa[1]); cv.u.y = pack2(sa[2], sa[3]); cv.u.z = pack2(sb[0], sb[1]); cv.u.w = pack2(sb[2], sb[3]);
        pf[m] = cv.v;
      }
#pragma unroll
      for (int e = 0; e < DV / 16; ++e) {
        bf16x8 vf = lds_frag(Vts, 16 * e + c, kb + 8 * g);
#pragma unroll
        for (int m = 0; m < NMAP; ++m) {
          f32x4 t = o[m][e] * alpha[m];
          o[m][e] = mfma16(vf, pf[m], t);
        }
      }
    }
  }
#pragma unroll
  for (int m = 0; m < NMAP; ++m) {
    float l = lsum[m];
    l += __shfl_xor(l, 16);
    l += __shfl_xor(l, 32);
    lsum[m] = l;
  }
}

__device__ __forceinline__ void item_diff_attn(const Params& p, int layer, bool lat, int b, int h, int qb, char* smem) {
  bf16_t* Ks = (bf16_t*)smem;
  bf16_t* Vts = Ks + 2 * 64 * LS;
  const int lane = get_tid() & 63, wave = __builtin_amdgcn_readfirstlane(get_tid() >> 6), c = lane & 15, g = lane >> 4;
  const bf16_t* parts = (const bf16_t*)(p.ws + W_PARTS);
  const bf16_t* vat = (const bf16_t*)(p.ws + W_VAT);
  const int row0 = lat ? NCTX + b * 1024 : b * 256;
  const int L = lat ? 1024 : 256;
  const int qrow_i = row0 + qb * 64 + 16 * wave + c;
  AttnSeg s0, s1;
  s0.k = parts + (size_t)row0 * LDP + PC_KA + h * 128; s0.ldk = LDP;
  s0.v = vat + (size_t)(h * 128) * MTOK + row0; s0.ldv = MTOK; s0.ntiles = L / 64;
  if (lat) {
    s1.k = (const bf16_t*)(p.ws + W_CKA) + (size_t)(b * 2 + layer) * 512 * 512 + h * 128; s1.ldk = 512;
    s1.v = (const bf16_t*)(p.ws + W_CVTA) + (size_t)(b * 2 + layer) * 512 * 512 + (size_t)(h * 128) * 512; s1.ldv = 512; s1.ntiles = 8;
  } else { s1 = s0; s1.ntiles = 0; }
  f32x4 o[2][8]; float ls[2];
  attn_core<2, 128, false>(parts + (size_t)qrow_i * LDP + PC_QA + h * 128, s0, s1, 0, 0, nullptr, Ks, Vts, o, ls);
  const float lam = ((const float*)(p.ws + W_LAM))[layer];
  const float li = lam_init_of(layer);
  const float i0 = 1.f / ls[0], i1 = lam / ls[1];
  float ss = 0.f;
#pragma unroll
  for (int e = 0; e < 8; ++e)
#pragma unroll
    for (int r = 0; r < 4; ++r) { float v = o[0][e][r] * i0 - o[1][e][r] * i1; o[0][e][r] = v; ss += v * v; }
  ss += __shfl_xor(ss, 16);
  ss += __shfl_xor(ss, 32);
  const float rstd = rsqrtf(ss * (1.f / 128.f) + EPS) * (1.f - li);
  const float* sg = p.subln_g + layer * 128;
  const bf16_t* ga = parts + (size_t)qrow_i * LDP + PC_GA + h * 128;
  bf16_t* ya = (bf16_t*)(p.ws + W_PARTS) + (size_t)qrow_i * LDP + PC_QA + h * 128;
#pragma unroll
  for (int e = 0; e < 8; ++e) {
    int ec = 16 * e + 4 * g;
    u32x2 gv = *(const u32x2*)(ga + ec);
    f32x4 sgv = *(const f32x4*)(sg + ec);
    float v0 = o[0][e][0] * rstd * sgv[0] * siluf(bflo(gv.x));
    float v1 = o[0][e][1] * rstd * sgv[1] * siluf(bfhi(gv.x));
    float v2 = o[0][e][2] * rstd * sgv[2] * siluf(bflo(gv.y));
    float v3 = o[0][e][3] * rstd * sgv[3] * siluf(bfhi(gv.y));
    u32x2 w; w.x = pack2(v0, v1); w.y = pack2(v2, v3);
    *(u32x2*)(ya + ec) = w;
  }
}

__device__ __forceinline__ void item_c_attn(const Params& p, int layer, bool lat, int b, int h, int qb, char* smem) {
  bf16_t* Ks = (bf16_t*)smem;
  bf16_t* Vts = Ks + 2 * 64 * LS;
  float* rpb_s = (float*)(Vts + 128 * LS);
  const int lane = get_tid() & 63, wave = __builtin_amdgcn_readfirstlane(get_tid() >> 6), c = lane & 15, g = lane >> 4;
  const bf16_t* parts = (const bf16_t*)(p.ws + W_PARTS);
  const bf16_t* vct = (const bf16_t*)(p.ws + W_VCT);
  f32x4 o[1][4]; float ls[1];
  int qrow_i;
  if (!lat) {
    const int row0 = b * 256;
    qrow_i = row0 + qb * 64 + 16 * wave + c;
    AttnSeg s0, s1;
    s0.k = parts + (size_t)row0 * LDP + PC_KC + h * 64; s0.ldk = LDP;
    s0.v = vct + (size_t)(h * 64) * MTOK + row0; s0.ldv = MTOK; s0.ntiles = 4;
    s1 = s0; s1.ntiles = 0;
    attn_core<1, 64, false>(parts + (size_t)qrow_i * LDP + PC_QC + h * 64, s0, s1, 0, 0, nullptr, Ks, Vts, o, ls);
  } else {
    const int row0 = NCTX + b * 1024;
    const int r = qb;
    qrow_i = row0 + r * 64 + 16 * wave + c;
    const int r0 = min(max(r - 4, 0), 8);
    __syncthreads();
    for (int i = get_tid(); i < 465; i += 256) rpb_s[i] = p.na_rpb[((size_t)layer * 8 + h) * 465 + i];
    __syncthreads();
    AttnSeg s0, s1;
    s0.k = (const bf16_t*)(p.ws + W_CKC) + (size_t)(b * 2 + layer) * 512 * 512 + h * 64; s0.ldk = 512;
    s0.v = (const bf16_t*)(p.ws + W_CVTC) + (size_t)(b * 2 + layer) * 512 * 512 + (size_t)(h * 64) * 512; s0.ldv = 512; s0.ntiles = 8;
    s1.k = parts + (size_t)(row0 + r0 * 64) * LDP + PC_KC + h * 64; s1.ldk = LDP;
    s1.v = vct + (size_t)(h * 64) * MTOK + row0 + r0 * 64; s1.ldv = MTOK; s1.ntiles = 8;
    attn_core<1, 64, true>(parts + (size_t)qrow_i * LDP + PC_QC + h * 64, s0, s1, 16 * wave + c, r0 - r + 7, rpb_s, Ks, Vts, o, ls);
  }
  const float inv = 1.f / ls[0];
  const bf16_t* gc = parts + (size_t)qrow_i * LDP + PC_GC + h * 64;
  bf16_t* yc = (bf16_t*)(p.ws + W_PARTS) + (size_t)qrow_i * LDP + PC_QC + h * 64;
#pragma unroll
  for (int e = 0; e < 4; ++e) {
    int ec = 16 * e + 4 * g;
    u32x2 gv = *(const u32x2*)(gc + ec);
    float v0 = o[0][e][0] * inv * siluf(bflo(gv.x));
    float v1 = o[0][e][1] * inv * siluf(bfhi(gv.x));
    float v2 = o[0][e][2] * inv * siluf(bflo(gv.y));
    float v3 = o[0][e][3] * inv * siluf(bfhi(gv.y));
    u32x2 w; w.x = pack2(v0, v1); w.y = pack2(v2, v3);
    *(u32x2*)(yc + ec) = w;
  }
}

DI int ssd_slot(bool lat, int b, int h, int d, int cd) { return lat ? 2048 + ((b * 8 + h) * 2 + d) * 16 + cd : ((b * 8 + h) * 2 + d) * 4 + cd; }

__device__ __forceinline__ void item_ssd1(const Params& p, int layer, bool lat, int b, int gq, int ch, char* smem) {
  bf16_t* Cs = (bf16_t*)smem;
  bf16_t* Bs = Cs + 64 * LS;
  bf16_t* BsT = Bs + 64 * LS;
  bf16_t* XsT = BsT + 64 * LS;
  float* acum = (float*)(XsT + 4 * 64 * LS);
  float* dts = acum + 512;
  const int tid = get_tid(), lane = tid & 63, wave = __builtin_amdgcn_readfirstlane(tid >> 6), c = lane & 15, g = lane >> 4;
  const int row0 = lat ? NCTX + b * 1024 : b * 256;
  const int L = lat ? 1024 : 256;
  const int nch = L / 64;
  const int tbase = row0 + 64 * ch;
  const bf16_t* parts = (const bf16_t*)(p.ws + W_PARTS);
  const float* dtg = (const float*)(p.ws + W_DT);
  float* eag = (float*)(p.ws + W_EA);
  bf16_t* ccg = (bf16_t*)(p.ws + W_CC);
  bf16_t* scg = (bf16_t*)(p.ws + W_HMOD);
  __syncthreads();
#pragma unroll
  for (int q = 0; q < 2; ++q) {
    const int hd = wave + 4 * q, d = hd >> 2, h = gq * 4 + (hd & 3);
    float raw = dtg[(size_t)(tbase + lane) * 16 + d * 8 + h] + p.dt_bias[(layer * 2 + d) * 8 + h];
    float dt = raw > 20.f ? raw : log1pf(expf(raw));
    float la = dt * (-expf(p.a_log[(layer * 2 + d) * 8 + h]));
    if (d == 0) {
#pragma unroll
      for (int off = 1; off < 64; off <<= 1) { float t = __shfl_up(la, off); if (lane >= off) la += t; }
    } else {
#pragma unroll
      for (int off = 1; off < 64; off <<= 1) { float t = __shfl_down(la, off); if (lane + off < 64) la += t; }
    }
    acum[hd * 64 + lane] = la; dts[hd * 64 + lane] = dt;
    eag[(size_t)(tbase + lane) * 16 + d * 8 + h] = __expf(la);
  }
#pragma unroll
  for (int grp = 0; grp < 3; ++grp) {
    u32x4 rv[4][5];
#pragma unroll
    for (int u = 0; u < 4; ++u) {
      const int it = grp * 4 + u;
      const int vi = tid + 256 * it;
      int i, chn;
      if (it < 8) { i = vi >> 5; chn = gq * 256 + (vi & 31) * 8; }
      else if (it < 10) { int rem = vi - 2048; i = rem >> 3; chn = 512 + gq * 64 + (rem & 7) * 8; }
      else { int rem = vi - 2560; i = rem >> 3; chn = 640 + gq * 64 + (rem & 7) * 8; }
      const int tok = 64 * ch + i;
#pragma unroll
      for (int k = 0; k < 5; ++k) {
        const int tt = tok + k - 2;
        rv[u][k] = (u32x4){0u, 0u, 0u, 0u};
        if (tt >= 0 && tt < L) rv[u][k] = *(const u32x4*)(parts + (size_t)(row0 + tt) * LDP + PC_XBC + chn);
      }
    }
#pragma unroll
    for (int u = 0; u < 4; ++u) {
      const int it = grp * 4 + u;
      const int vi = tid + 256 * it;
      int i, cc, chn;
      if (it < 8) { i = vi >> 5; cc = (vi & 31) * 8; chn = gq * 256 + cc; }
      else if (it < 10) { int rem = vi - 2048; i = rem >> 3; cc = (rem & 7) * 8; chn = 512 + gq * 64 + cc; }
      else { int rem = vi - 2560; i = rem >> 3; cc = (rem & 7) * 8; chn = 640 + gq * 64 + cc; }
      float a8[8];
      {
        const float* cb = p.conv_b + layer * 768 + chn;
        f32x4 b0 = *(const f32x4*)cb, b1 = *(const f32x4*)(cb + 4);
        a8[0] = b0[0]; a8[1] = b0[1]; a8[2] = b0[2]; a8[3] = b0[3]; a8[4] = b1[0]; a8[5] = b1[1]; a8[6] = b1[2]; a8[7] = b1[3];
      }
#pragma unroll
      for (int k = 0; k < 5; ++k) {
        float f[8]; unpack8(rv[u][k], f);
        const float* cw = p.conv_w + (size_t)(layer * 5 + k) * 768 + chn;
        f32x4 w0 = *(const f32x4*)cw, w1 = *(const f32x4*)(cw + 4);
        a8[0] += w0[0] * f[0]; a8[1] += w0[1] * f[1]; a8[2] += w0[2] * f[2]; a8[3] += w0[3] * f[3];
        a8[4] += w1[0] * f[4]; a8[5] += w1[1] * f[5]; a8[6] += w1[2] * f[6]; a8[7] += w1[3] * f[7];
      }
#pragma unroll
      for (int j = 0; j < 8; ++j) a8[j] = siluf(a8[j]);
      if (it < 8) {
        bf16_t* xd = XsT + (cc >> 6) * 64 * LS + (cc & 63) * LS + i;
#pragma unroll
        for (int j = 0; j < 8; ++j) xd[j * LS] = f2bf(a8[j]);
      } else {
        u32x4 w; w.x = pack2(a8[0], a8[1]); w.y = pack2(a8[2], a8[3]); w.z = pack2(a8[4], a8[5]); w.w = pack2(a8[6], a8[7]);
        if (it < 10) {
          *(u32x4*)(Bs + i * LS + cc) = w;
#pragma unroll
          for (int j = 0; j < 8; ++j) BsT[(cc + j) * LS + i] = f2bf(a8[j]);
        } else {
          *(u32x4*)(Cs + i * LS + cc) = w;
          *(u32x4*)(ccg + (size_t)(tbase + i) * 128 + gq * 64 + cc) = w;
        }
      }
    }
  }
  __syncthreads();
  const int il = 16 * wave + c;
  bf16x8 cf[2];
  cf[0] = lds_frag(Cs, il, 8 * g); cf[1] = lds_frag(Cs, il, 32 + 8 * g);
  f32x4 ga[2], gb[2];
#pragma unroll
  for (int T = 0; T < 2; ++T) {
    ga[T] = (f32x4){0.f, 0.f, 0.f, 0.f}; gb[T] = ga[T];
    const int jrow = 32 * T + 8 * (c >> 2) + (c & 3);
#pragma unroll
    for (int ks = 0; ks < 2; ++ks) {
      ga[T] = mfma16(lds_frag(Bs, jrow, 32 * ks + 8 * g), cf[ks], ga[T]);
      gb[T] = mfma16(lds_frag(Bs, jrow + 4, 32 * ks + 8 * g), cf[ks], gb[T]);
    }
  }
  float btf[2][8];
#pragma unroll
  for (int ks = 0; ks < 2; ++ks) {
    u32x4 v = *(const u32x4*)(BsT + (16 * wave + c) * LS + 32 * ks + 8 * g);
    unpack8(v, btf[ks]);
  }
#pragma unroll 1
  for (int hd = 0; hd < 8; ++hd) {
    const int d = hd >> 2, hp = hd & 3, h = gq * 4 + hp;
    const float* ac = acum + hd * 64;
    const float* dtv = dts + hd * 64;
    const bf16_t* Xh = XsT + hp * 64 * LS;
    const float ai = ac[il];
    f32x4 yacc[4];
#pragma unroll
    for (int pt = 0; pt < 4; ++pt) yacc[pt] = (f32x4){0.f, 0.f, 0.f, 0.f};
#pragma unroll
    for (int T = 0; T < 2; ++T) {
      const bool skipT = (d == 0) ? (T == 1 && wave < 2) : (T == 0 && wave >= 2);
      if (!skipT) {
        float pa[4], pb[4];
#pragma unroll
        for (int r = 0; r < 4; ++r) {
          const int j0 = 32 * T + 8 * g + r, j1 = j0 + 4;
          const bool ok0 = (d == 0) ? (j0 <= il) : (j0 >= il);
          const bool ok1 = (d == 0) ? (j1 <= il) : (j1 >= il);
          const float f0 = ok0 ? __expf(fminf(ai - ac[j0], 0.f)) * dtv[j0] : 0.f;
          const float f1 = ok1 ? __expf(fminf(ai - ac[j1], 0.f)) * dtv[j1] : 0.f;
          pa[r] = ga[T][r] * f0; pb[r] = gb[T][r] * f1;
        }
        union { u32x4 u; bf16x8 v; } cv;
        cv.u.x = pack2(pa[0], pa[1]); cv.u.y = pack2(pa[2], pa[3]); cv.u.z = pack2(pb[0], pb[1]); cv.u.w = pack2(pb[2], pb[3]);
#pragma unroll
        for (int pt = 0; pt < 4; ++pt) yacc[pt] = mfma16(lds_frag(Xh, 16 * pt + c, 32 * T + 8 * g), cv.v, yacc[pt]);
      }
    }
    if (d == 0) {
      const float dsk = p.d_skip[(layer * 2 + 0) * 8 + h] + p.d_skip[(layer * 2 + 1) * 8 + h];
#pragma unroll
      for (int pt = 0; pt < 4; ++pt)
#pragma unroll
        for (int r = 0; r < 4; ++r) yacc[pt][r] += dsk * bf2f(Xh[(16 * pt + 4 * g + r) * LS + il]);
    }
    {
      bf16_t* yo = (bf16_t*)(p.ws + (d == 0 ? W_YBF : W_YBB)) + (size_t)(tbase + il) * 512 + h * 64 + 4 * g;
#pragma unroll
      for (int pt = 0; pt < 4; ++pt) {
        u32x2 w; w.x = pack2(yacc[pt][0], yacc[pt][1]); w.y = pack2(yacc[pt][2], yacc[pt][3]);
        *(u32x2*)(yo + 16 * pt) = w;
      }
    }
    {
      const float aend = (d == 0) ? ac[63] : ac[0];
      bf16x8 aw[2];
#pragma unroll
      for (int ks = 0; ks < 2; ++ks) {
        float s8[8];
#pragma unroll
        for (int e = 0; e < 8; ++e) { const int j = 32 * ks + 8 * g + e; s8[e] = btf[ks][e] * dtv[j] * __expf(aend - ac[j]); }
        union { u32x4 u; bf16x8 v; } cv;
        cv.u.x = pack2(s8[0], s8[1]); cv.u.y = pack2(s8[2], s8[3]); cv.u.z = pack2(s8[4], s8[5]); cv.u.w = pack2(s8[6], s8[7]);
        aw[ks] = cv.v;
      }
      const int cd = (d == 0) ? ch : nch - 1 - ch;
      bf16_t* so = scg + (size_t)ssd_slot(lat, b, h, d, cd) * 4096 + 16 * wave + 4 * g;
#pragma unroll
      for (int pt = 0; pt < 4; ++pt) {
        f32x4 t = (f32x4){0.f, 0.f, 0.f, 0.f};
#pragma unroll
        for (int ks = 0; ks < 2; ++ks) t = mfma16(aw[ks], lds_frag(Xh, 16 * pt + c, 32 * ks + 8 * g), t);
        u32x2 w; w.x = pack2(t[0], t[1]); w.y = pack2(t[2], t[3]);
        *(u32x2*)(so + (16 * pt + c) * 64) = w;
      }
    }
  }
}

template <int NCH>
DI void ssd_scan_chain(const Params& p, int layer, bool lat, int b, int h, int d, int half) {
  const int tid = get_tid();
  const int e = half * 2048 + tid * 8;
  const int row0 = lat ? NCTX + b * 1024 : b * 256;
  bf16_t* sc = (bf16_t*)(p.ws + W_HMOD) + (size_t)ssd_slot(lat, b, h, d, 0) * 4096 + e;
  const float* eag = (const float*)(p.ws + W_EA);
  float hr[8];
  if (lat) {
    const float* h0 = p.state_ssd + ((size_t)((b * 2 + layer) * 2 + d) * 8 + h) * 4096 + e;
    f32x4 a = *(const f32x4*)h0, bq = *(const f32x4*)(h0 + 4);
    hr[0] = a[0]; hr[1] = a[1]; hr[2] = a[2]; hr[3] = a[3]; hr[4] = bq[0]; hr[5] = bq[1]; hr[6] = bq[2]; hr[7] = bq[3];
  } else {
#pragma unroll
    for (int j = 0; j < 8; ++j) hr[j] = 0.f;
  }
  u32x4 tmp[NCH];
  float dec[NCH];
#pragma unroll
  for (int cd = 0; cd < NCH; ++cd) {
    tmp[cd] = *(const u32x4*)(sc + (size_t)cd * 4096);
    const int cf = d ? NCH - 1 - cd : cd;
    dec[cd] = eag[(size_t)(row0 + 64 * cf + (d ? 0 : 63)) * 16 + d * 8 + h];
  }
#pragma unroll
  for (int cd = 0; cd < NCH; ++cd) {
    u32x4 w; w.x = pack2(hr[0], hr[1]); w.y = pack2(hr[2], hr[3]); w.z = pack2(hr[4], hr[5]); w.w = pack2(hr[6], hr[7]);
    *(u32x4*)(sc + (size_t)cd * 4096) = w;
    float f[8]; unpack8(tmp[cd], f);
#pragma unroll
    for (int j = 0; j < 8; ++j) hr[j] = dec[cd] * hr[j] + f[j];
  }
  if (!lat) {
    float* ho = p.out + O_SS + ((size_t)((b * 2 + layer) * 2 + d) * 8 + h) * 4096 + e;
    __builtin_nontemporal_store((f32x4){hr[0], hr[1], hr[2], hr[3]}, (f32x4*)ho);
    __builtin_nontemporal_store((f32x4){hr[4], hr[5], hr[6], hr[7]}, (f32x4*)(ho + 4));
  }
}

__device__ __forceinline__ void phase_ssd_scan(const Params& p, int layer) {
  for (int i = blockIdx.x * 256 + get_tid(); i < MTOK; i += gridDim.x * 256) ((float*)(p.ws + W_RSTD))[i] = 0.f;
  for (int it = blockIdx.x; it < 1088; it += gridDim.x) {
    const int chain = it >> 1, half = it & 1;
    if (chain < 512) ssd_scan_chain<4>(p, layer, false, chain >> 4, (chain >> 1) & 7, chain & 1, half);
    else { const int cl = chain - 512; ssd_scan_chain<16>(p, layer, true, cl >> 4, (cl >> 1) & 7, cl & 1, half); }
  }
}

__device__ __forceinline__ void phase_ssd_final(const Params& p, int layer, char* smem) {
  bf16_t* Cs2 = (bf16_t*)smem;
  bf16_t* Hs = Cs2 + 2 * 64 * LS;
  float* eas = (float*)(Hs + 2 * 64 * LS);
  const int tid = get_tid(), lane = tid & 63, wave = __builtin_amdgcn_readfirstlane(tid >> 6), c = lane & 15, g = lane >> 4;
  const bf16_t* parts = (const bf16_t*)(p.ws + W_PARTS);
  const bf16_t* scg = (const bf16_t*)(p.ws + W_HMOD);
  const bf16_t* ccg = (const bf16_t*)(p.ws + W_CC);
  const float* eag = (const float*)(p.ws + W_EA);
  bf16_t* yf = (bf16_t*)(p.ws + W_YBF);
  const bf16_t* ybk = (const bf16_t*)(p.ws + W_YBB);
  const float* ng = p.ssd_norm_g + layer * 512;
  for (int it2 = blockIdx.x; it2 < 320; it2 += gridDim.x) {
    const int it = it2 >> 1, hh = it2 & 1;
    const bool lat = it >= 128;
    const int b = lat ? (it - 128) >> 4 : it >> 2;
    const int ch = lat ? (it - 128) & 15 : it & 3;
    const int nch = lat ? 16 : 4;
    const int tbase = (lat ? NCTX + b * 1024 : b * 256) + 64 * ch;
    __syncthreads();
#pragma unroll
    for (int i4 = 0; i4 < 4; ++i4) {
      int vi = tid + 256 * i4; int i = vi >> 4, cc = (vi & 15) * 8;
      u32x4 v = *(const u32x4*)(ccg + (size_t)(tbase + i) * 128 + cc);
      *(u32x4*)(Cs2 + (cc >> 6) * 64 * LS + i * LS + (cc & 63)) = v;
    }
    *(f32x4*)(eas + tid * 4) = *(const f32x4*)(eag + (size_t)tbase * 16 + tid * 4);
    const int il = 16 * wave + c;
    const size_t row = (size_t)(tbase + il);
    u32x4 hreg[2];
    {
      const bf16_t* s = scg + (size_t)ssd_slot(lat, b, 4 * hh, 0, ch) * 4096;
      hreg[0] = *(const u32x4*)(s + tid * 8); hreg[1] = *(const u32x4*)(s + 2048 + tid * 8);
    }
    float ss = 0.f;
#pragma unroll 1
    for (int h = 4 * hh; h < 4 * hh + 4; ++h) {
      f32x4 y[4];
#pragma unroll
      for (int pt = 0; pt < 4; ++pt) y[pt] = (f32x4){0.f, 0.f, 0.f, 0.f};
#pragma unroll
      for (int d = 0; d < 2; ++d) {
        bf16_t* Hb = Hs + d * 64 * LS;
        {
          int e0 = tid * 8;
          *(u32x4*)(Hb + (e0 >> 6) * LS + (e0 & 63)) = hreg[0];
          *(u32x4*)(Hb + ((e0 + 2048) >> 6) * LS + (e0 & 63)) = hreg[1];
        }
        __syncthreads();
        {
          const int k1 = 2 * h + d + 1;
          if (k1 < 8 * hh + 8) {
            const int h2 = k1 >> 1, d2 = k1 & 1;
            const bf16_t* s = scg + (size_t)ssd_slot(lat, b, h2, d2, d2 ? nch - 1 - ch : ch) * 4096;
            hreg[0] = *(const u32x4*)(s + tid * 8); hreg[1] = *(const u32x4*)(s + 2048 + tid * 8);
          }
        }
        const bf16_t* Cq = Cs2 + (h >> 2) * 64 * LS;
        const bf16x8 c0 = lds_frag(Cq, il, 8 * g), c1 = lds_frag(Cq, il, 32 + 8 * g);
        const float ea = eas[il * 16 + d * 8 + h];
#pragma unroll
        for (int pt = 0; pt < 4; ++pt) {
          f32x4 t = (f32x4){0.f, 0.f, 0.f, 0.f};
          t = mfma16(lds_frag(Hb, 16 * pt + c, 8 * g), c0, t);
          t = mfma16(lds_frag(Hb, 16 * pt + c, 32 + 8 * g), c1, t);
          y[pt] += t * ea;
        }
      }
#pragma unroll
      for (int pt = 0; pt < 4; ++pt) {
        const int col = h * 64 + 16 * pt + 4 * g;
        u32x2 a = *(const u32x2*)(yf + row * 512 + col);
        u32x2 bq = *(const u32x2*)(ybk + row * 512 + col);
        u32x2 z = *(const u32x2*)(parts + row * LDP + PC_Z + col);
        f32x4 gv = *(const f32x4*)(ng + col);
        float y0 = (y[pt][0] + bflo(a.x) + bflo(bq.x)) * siluf(bflo(z.x));
        float y1 = (y[pt][1] + bfhi(a.x) + bfhi(bq.x)) * siluf(bfhi(z.x));
        float y2 = (y[pt][2] + bflo(a.y) + bflo(bq.y)) * siluf(bflo(z.y));
        float y3 = (y[pt][3] + bfhi(a.y) + bfhi(bq.y)) * siluf(bfhi(z.y));
        ss += y0 * y0 + y1 * y1 + y2 * y2 + y3 * y3;
        u32x2 w; w.x = pack2(y0 * gv[0], y1 * gv[1]); w.y = pack2(y2 * gv[2], y3 * gv[3]);
        *(u32x2*)(yf + row * 512 + col) = w;
      }
    }
    ss += __shfl_xor(ss, 16);
    ss += __shfl_xor(ss, 32);
    if (g == 0) atomicAdd((float*)(p.ws + W_RSTD) + row, ss);
  }
}

__device__ __forceinline__ void phase_mixers(const Params& p, int layer, char* smem) {
  constexpr int N0 = 128, N1 = N0 + 256, N2 = N1 + 64, N3 = N2 + 256, N4 = N3 + 512, N5 = N4 + 1024;
  __shared__ int s_item;
  unsigned* ctr = (unsigned*)(p.ws + W_BAR) + 3584 + 64 * layer;
  for (;;) {
    __syncthreads();
    if (threadIdx.x == 0) s_item = (int)atomicAdd(ctr, 1u);
    __syncthreads();
    const int it = __builtin_amdgcn_readfirstlane(s_item);
    if (it >= N5) break;
    if (it < N0) { int j = it; item_diff_attn(p, layer, true, j >> 6, (j >> 4) & 3, j & 15, smem); }
    else if (it < N1) { int j = it - N0; item_c_attn(p, layer, true, j >> 7, (j >> 4) & 7, j & 15, smem); }
    else if (it < N2) { int j = it - N1; item_ssd1(p, layer, true, j >> 5, (j >> 4) & 1, j & 15, smem); }
    else if (it < N3) { int j = it - N2; item_ssd1(p, layer, false, j >> 3, (j >> 2) & 1, j & 3, smem); }
    else if (it < N4) { int j = it - N3; item_diff_attn(p, layer, false, j >> 4, (j >> 2) & 3, j & 3, smem); }
    else { int j = it - N4; item_c_attn(p, layer, false, j >> 5, (j >> 2) & 7, j & 3, smem); }
  }
}

__device__ __forceinline__ void phase_branch(const Params& p, int layer, char* smem) {
  const int tid = get_tid(), lane = tid & 63, wave = __builtin_amdgcn_readfirstlane(tid >> 6), wm = wave >> 1, wn = wave & 1, c = lane & 15, g = lane >> 4;
  const bf16_t* parts = (const bf16_t*)(p.ws + W_PARTS);
  const int ntiles = 64 * 8;
  for (int t = blockIdx.x; t < ntiles; t += gridDim.x) {
    const int m0 = (t % 64) * 160, n0 = (t / 64) * 128;
    const int mb = m0 + 80 * wm, nb = n0 + 64 * wn;
    f32x4 tot[5][4];
    zero_acc<5, 4>(tot);
#pragma unroll 1
    for (int br = 0; br < 3; ++br) {
      const bf16_t* A = (br == 0) ? parts + PC_QA : (br == 1 ? (const bf16_t*)(p.ws + W_YBF) : parts + PC_QC);
      const int lda = (br == 1) ? 512 : LDP;
      const bf16_t* Bt = (const bf16_t*)(p.ws + W_WTBR) + (size_t)(layer * 3 + br) * 1024 * 512;
      f32x4 acc[5][4];
      zero_acc<5, 4>(acc);
      gemm_mainloop_dma_sw<true, 4>(A + (size_t)m0 * lda, lda, Bt + (size_t)n0 * 512, 512, 512, acc, smem);
      int lane_e = lane; asm volatile("" : "+v"(lane_e));
      const int ce = lane_e & 15, ge = lane_e >> 4;
#pragma unroll
      for (int mt = 0; mt < 5; ++mt) {
        const int tok = mb + 16 * mt + ce;
        const float rs = (br == 1) ? rsqrtf(((const float*)(p.ws + W_RSTD))[tok] * (1.f / 512.f) + EPS) : 1.f;
#pragma unroll
        for (int q = 0; q < 2; ++q) {
          const u32x4 v = __builtin_nontemporal_load((const u32x4*)(parts + (size_t)tok * LDP + PC_MG + br * 1024 + nb + 32 * q + 8 * ge));
          tot[mt][2 * q][0] += sigmf(bflo(v.x)) * rs * acc[mt][2 * q][0];
          tot[mt][2 * q][1] += sigmf(bfhi(v.x)) * rs * acc[mt][2 * q][1];
          tot[mt][2 * q][2] += sigmf(bflo(v.y)) * rs * acc[mt][2 * q][2];
          tot[mt][2 * q][3] += sigmf(bfhi(v.y)) * rs * acc[mt][2 * q][3];
          tot[mt][2 * q + 1][0] += sigmf(bflo(v.z)) * rs * acc[mt][2 * q + 1][0];
          tot[mt][2 * q + 1][1] += sigmf(bfhi(v.z)) * rs * acc[mt][2 * q + 1][1];
          tot[mt][2 * q + 1][2] += sigmf(bflo(v.w)) * rs * acc[mt][2 * q + 1][2];
          tot[mt][2 * q + 1][3] += sigmf(bfhi(v.w)) * rs * acc[mt][2 * q + 1][3];
        }
      }
    }
#pragma unroll
    for (int mt = 0; mt < 5; ++mt) {
      const int tok = mb + 16 * mt + c;
#pragma unroll
      for (int q = 0; q < 2; ++q) {
        u32x4 w;
        w.x = pack2(tot[mt][2 * q][0], tot[mt][2 * q][1]); w.y = pack2(tot[mt][2 * q][2], tot[mt][2 * q][3]);
        w.z = pack2(tot[mt][2 * q + 1][0], tot[mt][2 * q + 1][1]); w.w = pack2(tot[mt][2 * q + 1][2], tot[mt][2 * q + 1][3]);
        *(u32x4*)((bf16_t*)(p.ws + W_HMOD) + (size_t)tok * 1024 + nb + 32 * q + 8 * g) = w;
      }
    }
  }
}

__device__ __forceinline__ void phase_outproj(const Params& p, int layer, char* smem) {
  const int tid = get_tid(), lane = tid & 63, wave = __builtin_amdgcn_readfirstlane(tid >> 6), wm = wave >> 1, wn = wave & 1, c = lane & 15, g = lane >> 4;
  const bf16_t* wt = (const bf16_t*)(p.ws + W_WTOUT) + (size_t)layer * 1024 * 1024;
  const int ntiles = 64 * 8;
  for (int t = blockIdx.x; t < ntiles; t += gridDim.x) {
    const int m0 = (t % 64) * 160, n0 = (t / 64) * 128;
    const int mb = m0 + 80 * wm, nb = n0 + 64 * wn;
    f32x4 acc[5][4];
    zero_acc<5, 4>(acc);
    gemm_mainloop_dma_sw<true>((const bf16_t*)(p.ws + W_HMOD) + (size_t)m0 * 1024, 1024, wt + (size_t)n0 * 1024, 1024, 1024, acc, smem);
#pragma unroll
    for (int mt = 0; mt < 5; ++mt) {
      const int tok = mb + 16 * mt + c;
      const float* xin = (layer == 0) ? (tok < NCTX ? p.x_prompt + (size_t)tok * 1024 : p.x_sample + (size_t)(tok - NCTX) * 1024)
                                      : p.out + (size_t)tok * 1024;
      const int v = tok < NCTX ? 0 : 1 + ((tok - NCTX) >> 10);
      const float* gate = (const float*)(p.ws + W_ADA) + (layer * 3 + v) * 3072 + 2048;
      float* xo = p.out + (size_t)tok * 1024;
#pragma unroll
      for (int nt = 0; nt < 4; ++nt) {
        const int col = nb + 32 * (nt >> 1) + 8 * g + 4 * (nt & 1);
        f32x4 xv = __builtin_nontemporal_load((const f32x4*)(xin + col));
        f32x4 gv = *(const f32x4*)(gate + col);
        *(f32x4*)(xo + col) = xv + gv * acc[mt][nt];
      }
    }
  }
}

__device__ __forceinline__ void phase_final(const Params& p) {
  const int lane = get_tid() & 63, wave = __builtin_amdgcn_readfirstlane(get_tid() >> 6);
  const int gw = blockIdx.x * 4 + wave, nw = gridDim.x * 4;
  for (int row = gw; row < MTOK; row += nw) {
    float* x = p.out + (size_t)row * 1024;
    float4 xv[4];
    float ss = 0.f;
#pragma unroll
    for (int i = 0; i < 4; ++i) {
      { const f32x4 t = __builtin_nontemporal_load((const f32x4*)(x + (i * 64 + lane) * 4)); xv[i] = make_float4(t[0], t[1], t[2], t[3]); }
      ss += xv[i].x * xv[i].x + xv[i].y * xv[i].y + xv[i].z * xv[i].z + xv[i].w * xv[i].w;
    }
    ss = wave_sum(ss);
    const float rstd = rsqrtf(ss * (1.f / 1024.f) + EPS);
#pragma unroll
    for (int i = 0; i < 4; ++i) {
      int col = (i * 64 + lane) * 4;
      float4 g = *(const float4*)(p.final_g + col);
      const f32x4 r = (f32x4){xv[i].x * rstd * g.x, xv[i].y * rstd * g.y, xv[i].z * rstd * g.z, xv[i].w * rstd * g.w};
      __builtin_nontemporal_store(r, (f32x4*)(x + col));
    }
  }
}

#define XB_TMO      128
#define XB_XCNT(j)  (256  + 64 * (j))
#define XB_XSUB(j)  (1280 + 64 * (j))
#define XB_XGEN(j)  (2304 + 64 * (j))
#define XB_TOP      3328
#define XB_TOPGEN   3392
#define XCD_BAR_WORDS 3456
#define XB_SPIN_CAP (1u << 22)
#define LAS __attribute__((address_space(3)))
DI unsigned xb_ld(unsigned* p) { return __hip_atomic_load(p, __ATOMIC_RELAXED, __HIP_MEMORY_SCOPE_AGENT); }
DI unsigned xb_add(unsigned* p, unsigned v) { return __hip_atomic_fetch_add(p, v, __ATOMIC_RELAXED, __HIP_MEMORY_SCOPE_AGENT); }
DI unsigned xb_xcc_id() { return (unsigned)__builtin_amdgcn_s_getreg((3 << 11) | 20) & 0xFu; }
#define XB_SPIN(cond, bar) do { unsigned _sp = 0; while (cond) { __builtin_amdgcn_s_sleep(1); \
    if ((++_sp & 255u) == 0u) { if (xb_ld(&(bar)[XB_TMO])) break; if (_sp > XB_SPIN_CAP) { atomicAdd(&(bar)[XB_TMO], 1u); break; } } } } while (0)
struct XcdBarrier { unsigned* bar; unsigned x; volatile LAS unsigned* st; };
DI XcdBarrier xcd_barrier_post(unsigned* bar, volatile LAS unsigned* st) {
  XcdBarrier b; b.bar = bar; b.x = xb_xcc_id(); b.st = st;
  if (threadIdx.x == 0) (void)xb_add(&bar[XB_XCNT(b.x)], 1u);
  return b;
}
DI void xcd_barrier_complete(unsigned* bar, unsigned x, unsigned& nloc, unsigned& nx) {
  const unsigned G = gridDim.x * gridDim.y * gridDim.z;
  unsigned sum, cnt, mine, sp = 0u;
  for (;;) {
    sum = 0u; cnt = 0u; mine = 0u;
#pragma unroll
    for (unsigned j = 0; j < 16; ++j) { const unsigned c = xb_ld(&bar[XB_XCNT(j)]); sum += c; cnt += (c > 0u) ? 1u : 0u; mine = (j == x) ? c : mine; }
    if (sum == G) break;
    __builtin_amdgcn_s_sleep(1);
    if ((++sp & 255u) == 0u) { if (xb_ld(&bar[XB_TMO])) break; if (sp > XB_SPIN_CAP) { atomicAdd(&bar[XB_TMO], 1u); break; } }
  }
  nloc = mine > 0u ? mine : 1u; nx = cnt > 0u ? cnt : 1u;
}
DI void xcd_barrier(const XcdBarrier& b) {
  asm volatile("s_waitcnt vmcnt(0)" ::: "memory");
  __syncthreads();
  if (threadIdx.x == 0) {
    unsigned* bar = b.bar;
    __builtin_amdgcn_s_waitcnt(0);
    unsigned nloc = b.st[0], nx = b.st[1];
    if (nloc == 0u) { xcd_barrier_complete(bar, b.x, nloc, nx); b.st[0] = nloc; b.st[1] = nx; }
    const unsigned old = xb_add(&bar[XB_XSUB(b.x)], 1u);
    const unsigned gen = old / nloc;
    if (old + 1u == (gen + 1u) * nloc) {
      __builtin_amdgcn_fence(__ATOMIC_RELEASE, "agent");
      asm volatile("s_waitcnt vmcnt(0)" ::: "memory");
      const unsigned og = xb_add(&bar[XB_TOP], 1u);
      const unsigned tg = og / nx;
      if (og + 1u == (tg + 1u) * nx) xb_add(&bar[XB_TOPGEN], 1u);
      else XB_SPIN(xb_ld(&bar[XB_TOPGEN]) == tg, bar);
      __builtin_amdgcn_fence(__ATOMIC_ACQUIRE, "agent");
      xb_add(&bar[XB_XGEN(b.x)], 1u);
      asm volatile("s_waitcnt vmcnt(0)" ::: "memory");
    } else {
      XB_SPIN(xb_ld(&bar[XB_XGEN(b.x)]) == gen, bar);
      __builtin_amdgcn_fence(__ATOMIC_ACQUIRE, "agent");
      asm volatile("s_waitcnt vmcnt(0)" ::: "memory");
    }
  }
  __syncthreads();
}

#if MULTI_LAUNCH
constexpr int NPHASE = 16;
DI void run_phase(const Params& p, int ph, char* smem) {
  if (ph == 0) { phase_prep(p, smem, 0, blockIdx.x, gridDim.x); phase_prep(p, smem, 1, blockIdx.x, gridDim.x); return; }
  if (ph == 15) { phase_final(p); return; }
  const int layer = (ph - 1) / 7, s = (ph - 1) % 7;
  switch (s) {
    case 0: phase_hmod(p, layer); break;
    case 1: phase_inproj(p, layer, smem); break;
    case 2: phase_mixers(p, layer, smem); break;
    case 3: phase_ssd_scan(p, layer); break;
    case 4: phase_ssd_final(p, layer, smem); break;
    case 5: phase_branch(p, layer, smem); break;
    default: phase_outproj(p, layer, smem); break;
  }
}
#endif

__global__ void __launch_bounds__(256, 2) mega_kernel(Params p) {
  __shared__ __attribute__((aligned(16))) char smem[SMEM_BYTES];
  __shared__ u32x4 xb_words;
  if (threadIdx.x == 0) xb_words = (u32x4){0u, 0u, 0u, 0u};
  __syncthreads();
  XcdBarrier xb = xcd_barrier_post((unsigned*)(p.ws + W_BAR), (volatile LAS unsigned*)&xb_words);
  if (p.ws == nullptr) cg::this_grid().sync();
  phase_prep(p, smem, 0, blockIdx.x, gridDim.x);
  xcd_barrier(xb);
#define LAYER_BODY(layer) \
    phase_hmod(p, layer); \
    xcd_barrier(xb); \
    phase_inproj(p, layer, smem); \
    xcd_barrier(xb); \
    phase_mixers(p, layer, smem); \
    xcd_barrier(xb); \
    phase_ssd_scan(p, layer); \
    xcd_barrier(xb); \
    phase_ssd_final(p, layer, smem); \
    if (layer == 0) { \
      const int nidle = (int)gridDim.x - 320; \
      if (nidle > 0) { \
        if ((int)blockIdx.x >= 320) phase_prep(p, smem, 1, blockIdx.x - 320, nidle, 0, 11 * nidle); \
        else phase_prep(p, smem, 1, blockIdx.x, 320, 11 * nidle, N_DEF); \
      } else phase_prep(p, smem, 1, blockIdx.x, gridDim.x); \
    } \
    xcd_barrier(xb); \
    phase_branch(p, layer, smem); \
    xcd_barrier(xb); \
    phase_outproj(p, layer, smem); \
    xcd_barrier(xb);
  LAYER_BODY(0)
  LAYER_BODY(1)
#undef LAYER_BODY
  phase_final(p);
}

#if MULTI_LAUNCH
__global__ void __launch_bounds__(256, 2) phase_kernel(Params p, int ph) {
  __shared__ __attribute__((aligned(16))) char smem[SMEM_BYTES];
  run_phase(p, ph, smem);
}
#endif

extern "C" void kernel_launch(void* const* d_in, const int* in_sizes, int n_in, void* d_out, int out_size, void* d_ws,
                              size_t ws_size, hipStream_t stream) {
  Params p{};
  const float** pp = (const float**)&p;
  for (int i = 0; i < 30; ++i) pp[i] = (const float*)d_in[i];
  p.out = (float*)d_out;
  p.ws = (char*)d_ws;
  if (ws_size < W_END) { fprintf(stderr, "workspace too small: %zu < %zu\n", ws_size, (size_t)W_END); return; }
#if MULTI_LAUNCH
  for (int ph = 0; ph < NPHASE; ++ph) hipLaunchKernelGGL(phase_kernel, dim3(512), dim3(256), 0, stream, p, ph);
#else
  static int grid_blocks = 0;
  if (!grid_blocks) {
    int dev = 0, cus = 0, per_cu = 0;
    hipGetDevice(&dev);
    hipDeviceGetAttribute(&cus, hipDeviceAttributeMultiprocessorCount, dev);
    hipOccupancyMaxActiveBlocksPerMultiprocessor(&per_cu, mega_kernel, 256, 0);
    if (per_cu > 2) per_cu = 2;
    grid_blocks = cus * per_cu;
  }
  (void)hipMemsetAsync((char*)d_ws + W_BAR, 0, 16384, stream);
  void* args[] = {&p};
  hipError_t e = hipLaunchCooperativeKernel((void*)mega_kernel, dim3(grid_blocks), dim3(256), args, 0, stream);
  if (e != hipSuccess) fprintf(stderr, "cooperative launch failed: %s (grid %d)\n", hipGetErrorString(e), grid_blocks);
#endif
}
```
